# Optimizing an MI355X kernel written in HIP

```python
import math
import jax, jax.numpy as jnp
from jax import lax
import numpy as np

D_MODEL = 2048
BATCH = 4
SEQ = 4096
DEPTH = 4

EPS = 1e-6
CHUNK = 128
A_GROUPS = 8
A_WIDTH = 1024
A_GROUP_DIM = A_WIDTH // A_GROUPS
B_WIDTH = 1024
SHORT_CONV = 3
ATTN_HEADS = 8
ATTN_HEAD_DIM = 128
C_WIDTH = ATTN_HEADS * ATTN_HEAD_DIM
IDX_HEADS = 16
IDX_HEAD_DIM = 64
TOPK_MAX = 256
Q_BLOCK = 128
NUM_BUCKETS = 32
MAX_DISTANCE = 128
NEG_INF = -1e30

SECTION_SIZES = (
    A_WIDTH, A_WIDTH, A_WIDTH,
    B_WIDTH, B_WIDTH, B_WIDTH, B_WIDTH,
    C_WIDTH, C_WIDTH, C_WIDTH, C_WIDTH,
    IDX_HEADS * IDX_HEAD_DIM, IDX_HEAD_DIM, IDX_HEADS,
    D_MODEL, D_MODEL, D_MODEL,
)
IN_COLS = 18512

kernel_name = "hybrid_gated_sgu_shortconv_dsa"


def rmsnorm(x, g):
    xf = x.astype(jnp.float32)
    y = xf * lax.rsqrt(jnp.mean(xf * xf, axis=-1, keepdims=True) + EPS)
    return (y * g.astype(jnp.float32)).astype(x.dtype)


def t5_bucket(dist):
    n = jnp.maximum(dist, 0)
    max_exact = NUM_BUCKETS // 2
    nf = jnp.maximum(n, 1).astype(jnp.float32)
    large = max_exact + (jnp.log(nf / max_exact) / math.log(MAX_DISTANCE / max_exact)
                         * (NUM_BUCKETS - max_exact)).astype(jnp.int32)
    large = jnp.minimum(large, NUM_BUCKETS - 1)
    return jnp.where(n < max_exact, n, large)


def split_columns(p):
    outs = []
    off = 0
    for size in SECTION_SIZES:
        outs.append(p[..., off:off + size])
        off += size
    return outs


def spatial_gating(u, v, ws, bias):
    b_, L, _ = v.shape
    n_chunks = L // CHUNK
    mask = jnp.tril(jnp.ones((CHUNK, CHUNK), dtype=bool))
    ws = jnp.where(mask[None], ws, jnp.zeros_like(ws))
    v5 = v.reshape(b_, n_chunks, CHUNK, A_GROUPS, A_GROUP_DIM)
    mixed = jnp.einsum('gts,bnsgc->bntgc', ws, v5) + bias.T[None, None, :, :, None]
    return u * mixed.reshape(b_, L, A_WIDTH)


def short_gated_conv(gate_b, gate_c, x_in, conv_w):
    cx = gate_c * x_in
    conv = lax.conv_general_dilated(
        cx, conv_w[:, None, :].astype(cx.dtype), window_strides=(1,),
        padding=[(SHORT_CONV - 1, 0)], dimension_numbers=('NWC', 'WIO', 'NWC'),
        feature_group_count=B_WIDTH)
    return gate_b * conv


def dsa_attention(q, k, v, iq, ik, iw, rel_bias, topk):
    b_, L, _ = q.shape
    nb = L // Q_BLOCK
    qb_all = q.reshape(b_, nb, Q_BLOCK, ATTN_HEADS, ATTN_HEAD_DIM).swapaxes(0, 1)
    iq_all = iq.reshape(b_, nb, Q_BLOCK, IDX_HEADS, IDX_HEAD_DIM).swapaxes(0, 1)
    iw_all = (iw * (IDX_HEADS ** -0.5 * IDX_HEAD_DIM ** -0.5)).reshape(
        b_, nb, Q_BLOCK, IDX_HEADS).swapaxes(0, 1)
    k4 = k.reshape(b_, L, ATTN_HEADS, ATTN_HEAD_DIM)
    v4 = v.reshape(b_, L, ATTN_HEADS, ATTN_HEAD_DIM)
    key_pos = jnp.arange(L, dtype=jnp.int32)
    starts = jnp.arange(nb, dtype=jnp.int32) * Q_BLOCK
    scale = ATTN_HEAD_DIM ** -0.5
    gather = jax.vmap(lambda tb, ib: tb[ib])

    def block(args):
        qb, iqb, iwb, start = args
        qpos = start + jnp.arange(Q_BLOCK, dtype=jnp.int32)
        rel = jax.nn.relu(jnp.einsum('bqhd,bsd->bqsh', iqb, ik))
        score = jnp.einsum('bqsh,bqh->bqs', rel, iwb).astype(jnp.float32)
        causal = key_pos[None, None, :] <= qpos[None, :, None]
        score = jnp.where(causal, score, NEG_INF)
        _, idx = lax.top_k(score, topk)
        k_sel = gather(k4, idx)
        v_sel = gather(v4, idx)
        dist = qpos[None, :, None] - idx
        bias = rel_bias[t5_bucket(dist)].astype(jnp.float32)
        logits = jnp.einsum('bqhd,bqkhd->bqhk', qb, k_sel).astype(jnp.float32) * scale
        logits = logits + jnp.transpose(bias, (0, 1, 3, 2))
        logits = jnp.where((dist >= 0)[:, :, None, :], logits, NEG_INF)
        p = jax.nn.softmax(logits, axis=-1)
        return jnp.einsum('bqhk,bqkhd->bqhd', p.astype(v_sel.dtype), v_sel)

    out = lax.map(block, (qb_all, iq_all, iw_all, starts))
    return out.swapaxes(0, 1).reshape(b_, L, C_WIDTH)


def setup_inputs(seed: int = 0) -> dict:
    key = jax.random.key(seed)
    ks = jax.random.split(key, 14)
    f32 = jnp.float32
    nrm = lambda k, shape, s: jax.random.normal(k, shape, f32) * s
    return {
        "x": nrm(ks[0], (BATCH, SEQ, D_MODEL), 1.0),
        "norm_g": 1.0 + nrm(ks[1], (DEPTH, D_MODEL), 0.02),
        "w_in": nrm(ks[2], (DEPTH, D_MODEL, IN_COLS), D_MODEL ** -0.5),
        "a_ws": nrm(ks[3], (DEPTH, A_GROUPS, CHUNK, CHUNK), CHUNK ** -0.5),
        "a_b": 1.0 + nrm(ks[4], (DEPTH, A_GROUPS, CHUNK), 0.1),
        "b_conv": nrm(ks[5], (DEPTH, SHORT_CONV, B_WIDTH), SHORT_CONV ** -0.5),
        "p_a": nrm(ks[6], (DEPTH, A_WIDTH, D_MODEL), A_WIDTH ** -0.5),
        "p_b": nrm(ks[7], (DEPTH, B_WIDTH, D_MODEL), B_WIDTH ** -0.5),
        "p_c": nrm(ks[8], (DEPTH, C_WIDTH, D_MODEL), C_WIDTH ** -0.5),
        "w_o": nrm(ks[9], (DEPTH, D_MODEL, D_MODEL), D_MODEL ** -0.5),
        "rel_bias": nrm(ks[10], (NUM_BUCKETS, ATTN_HEADS), 0.5),
        "final_g": 1.0 + nrm(ks[11], (D_MODEL,), 0.02),
    }


def reference(x, norm_g, w_in, a_ws, a_b, b_conv, p_a, p_b, p_c, w_o, rel_bias, final_g):
    L = x.shape[1]
    topk = min(TOPK_MAX, L // 4)
    for l in range(DEPTH):
        h = rmsnorm(x, norm_g[l])
        proj = jnp.einsum('bsd,de->bse', h, w_in[l])
        (a_u, a_v, a_z, b_bg, b_cg, b_x, b_z, c_q, c_k, c_v, c_z,
         i_q, i_k, i_w, g_a, g_b, g_c) = split_columns(proj)
        y_a = spatial_gating(a_u, a_v, a_ws[l], a_b[l]) * jax.nn.silu(a_z)
        y_b = short_gated_conv(b_bg, b_cg, b_x, b_conv[l]) * jax.nn.silu(b_z)
        y_c = dsa_attention(c_q, c_k, c_v, i_q, i_k, i_w, rel_bias, topk) * jax.nn.silu(c_z)
        m = (jax.nn.sigmoid(g_a) * (y_a @ p_a[l])
             + jax.nn.sigmoid(g_b) * (y_b @ p_b[l])
             + jax.nn.sigmoid(g_c) * (y_c @ p_c[l]))
        x = x + m @ w_o[l]
    return rmsnorm(x, final_g)
```

```cpp
#include <hip/hip_runtime.h>
#include <hip/hip_cooperative_groups.h>
#include <cstdio>
#include <cmath>
namespace cg = cooperative_groups;

#ifndef MULTI_LAUNCH
#define MULTI_LAUNCH 0
#endif

#ifndef PROBE_MIX
#define PROBE_MIX 0
#endif
#ifndef PROBE_DUP
#define PROBE_DUP 0
#endif
#define LAS __attribute__((address_space(3)))
typedef unsigned short bf16_t;
typedef short bf16x8 __attribute__((ext_vector_type(8)));
typedef float f32x4 __attribute__((ext_vector_type(4)));
typedef float f32x16 __attribute__((ext_vector_type(16)));
typedef unsigned u32x4 __attribute__((ext_vector_type(4)));
typedef unsigned u32x2 __attribute__((ext_vector_type(2)));

constexpr int DM = 2048, NB = 4, SL = 4096, DEPTH = 4, MT = NB * SL;
constexpr int INC = 18512;
constexpr int NP = 18688;
constexpr int AU = 0, AV = 1024, AZ = 2048, BB = 3072, BC = 4096, BX = 5120, BZ = 6144, CQ = 7168, CK = 8192, CV = 9216, CZ = 10240,
              IQ = 11264, IK = 12288, IW = 12352, GA = 12416, GB = 14464, GC = 16512;
constexpr int NPHASES = 1 + 7 * DEPTH;

constexpr size_t WS_WTIN = 0;
constexpr size_t SZ_WTIN1 = (size_t)NP * DM * 2;
constexpr size_t WS_WTPA = WS_WTIN + SZ_WTIN1 * DEPTH;
constexpr size_t SZ_WTP1 = (size_t)DM * 1024 * 2;
constexpr size_t WS_WTPB = WS_WTPA + SZ_WTP1 * DEPTH;
constexpr size_t WS_WTPC = WS_WTPB + SZ_WTP1 * DEPTH;
constexpr size_t WS_WTO = WS_WTPC + SZ_WTP1 * DEPTH;
constexpr size_t SZ_WTO1 = (size_t)DM * DM * 2;
constexpr size_t WS_AWS = WS_WTO + SZ_WTO1 * DEPTH;
constexpr size_t SZ_AWS1 = (size_t)8 * 128 * 128 * 2;
constexpr size_t WS_H = WS_AWS + SZ_AWS1 * DEPTH;
constexpr size_t WS_P = WS_H + (size_t)MT * DM * 2;
constexpr size_t WS_X = WS_P + (size_t)MT * NP * 2;
constexpr size_t WS_YA = WS_X + (size_t)MT * DM * 4;
constexpr size_t WS_YB = WS_YA + (size_t)MT * 1024 * 2;
constexpr size_t WS_YC = WS_YB + (size_t)MT * 1024 * 2;
constexpr size_t WS_T = WS_YC + (size_t)MT * 1024 * 2;
constexpr size_t WS_MM = WS_T + (size_t)MT * DM * 4;
constexpr size_t WS_S = WS_MM + (size_t)MT * DM * 2;
constexpr size_t WS_MASK = WS_S + (size_t)MT * SL * 4;
constexpr size_t WS_VT = WS_MASK + (size_t)MT * 64 * 8;
constexpr size_t WS_BAR = WS_VT + (size_t)MT * 1024 * 2;
constexpr size_t WS_END = WS_BAR + 16384;

constexpr size_t WS_IKF = WS_S;
constexpr int LDS_BYTES = 131072 + 64;

struct Params {
    const float *x, *norm_g, *w_in, *a_ws, *a_b, *b_conv, *p_a, *p_b, *p_c, *w_o, *rel_bias, *final_g;
    float* out;
    unsigned char* ws;
    int ph_lo, ph_hi;
};

__device__ __forceinline__ unsigned cvt_pk_bf16(float lo, float hi) { unsigned r; asm("v_cvt_pk_bf16_f32 %0, %1, %2" : "=v"(r) : "v"(lo), "v"(hi)); return r; }
__device__ __forceinline__ int otid() { int t = __builtin_amdgcn_workitem_id_x(); asm volatile("" : "+v"(t)); return t; }
__device__ __forceinline__ float bf_lo(unsigned w) { return __uint_as_float(w << 16); }
__device__ __forceinline__ float bf_hi(unsigned w) { return __uint_as_float(w & 0xffff0000u); }
__device__ __forceinline__ float bf2f(bf16_t b) { return __uint_as_float(((unsigned)b) << 16); }
__device__ __forceinline__ float fast_exp2(float x) { return __builtin_amdgcn_exp2f(x); }
__device__ __forceinline__ float sigmoidf_(float x) { return __builtin_amdgcn_rcpf(1.0f + __expf(-x)); }
__device__ __forceinline__ float siluf_(float x) { return x * sigmoidf_(x); }

namespace pg8 {
constexpr int BM = 256, BK = 64, HALF = 128, HTB = HALF * BK * 2, STAGE_BYTES = 8 * HTB, NXCD = 8, WGM = 8;
__host__ __device__ __forceinline__ int lds_byte(int r, int c) { const int st = (r >> 4) * 2 + (c >> 5), rr = r & 15, cc = c & 31, ob = rr * 64 + cc * 2; return st * 1024 + (ob ^ (((ob >> 9) & 1) << 5)); }
__host__ __device__ __forceinline__ void stage_rc(int b, int& R, int& C) { const int st = b / 1024, sb = b % 1024, swz = sb ^ (((sb >> 9) & 1) << 5); R = (st >> 1) * 16 + swz / 64; C = (st & 1) * 32 + (swz % 64) / 2; }
__host__ __device__ __forceinline__ int perm32(int rho) { const int n = rho >> 4, i = rho & 15; return 8 * (i >> 2) + 4 * n + (i & 3); }
struct Unit { int pm, pn; };
struct Gemm { const bf16_t* A; const bf16_t* Bt; int M, N, K; };
struct StaticOrder {
    int nM, nN, nwg, G, c;
    __host__ __device__ void init(int M, int N, int G_, int c_) { nM = M / BM; nN = N / BM; nwg = nM * nN; G = G_; c = c_; }
    __host__ __device__ bool next(int i, Unit& u) const {
        const int L = i * G + c; if (L >= nwg) return false;
        const int wgid = (L & 7) * (nwg >> 3) + (L >> 3);
        int gid, within;
        if (nN == 8) { gid = wgid >> 6; within = wgid & 63; } else { gid = wgid / 584; within = wgid - gid * 584; }
        u.pm = gid * 8 + (within & 7); u.pn = within >> 3; return true;
    }
};

template <class Epi>
__device__ __forceinline__ void gemm_phase(LAS unsigned char* lds, const Gemm g, const StaticOrder& S, const Epi& E) {
    const int tid = otid(), wid = __builtin_amdgcn_readfirstlane(tid >> 6), lane = tid & 63, wr = wid >> 2, wc = wid & 3, fr = lane & 15, fq = lane >> 4;
    const int K = g.K, nt = K / BK;
    unsigned voffA[2], voffB[2];
#pragma unroll
    for (int i = 0; i < 2; ++i) { int R, C; stage_rc(tid * 16 + i * 8192, R, C); const int Rb = (R & ~31) + perm32(R & 31);
        voffA[i] = (unsigned)(R * K + C) * 2u; voffB[i] = (unsigned)(Rb * K + C) * 2u; }
    const size_t kstep = (size_t)(BK * 2);
    const size_t hstep = (size_t)HALF * K * 2;
    const size_t tstep = 2 * hstep;
    const unsigned ldsw = (unsigned)wid * 1024u;
    const int aoff = lds_byte(wr * 64 + fr, fq * 8), boff = lds_byte(wc * 32 + fr, fq * 8);
#define PG8_SA(b, h) (((b) * 2 + (h)) * HTB)
#define PG8_SB(b, h) ((4 + (b) * 2 + (h)) * HTB)
#define PG8_STAGE(bufoff, gbase, voff) do { _Pragma("unroll") for (int _i = 0; _i < 2; ++_i) \
        __builtin_amdgcn_global_load_lds((const unsigned*)((const char*)(gbase) + (voff)[_i]), (LAS unsigned*)(lds + (bufoff) + ldsw + _i * 8192), 16, 0, 0); } while (0)
#define PG8_LDA(dst, b, h) do { _Pragma("unroll") for (int m = 0; m < 4; ++m) _Pragma("unroll") for (int k = 0; k < 2; ++k) dst[m][k] = *(const LAS bf16x8*)(lds + PG8_SA(b, h) + aoff + m * 2048 + k * 1024); } while (0)
#define PG8_LDB(dst, b, h) do { _Pragma("unroll") for (int n = 0; n < 2; ++n) _Pragma("unroll") for (int k = 0; k < 2; ++k) dst[n][k] = *(const LAS bf16x8*)(lds + PG8_SB(b, h) + boff + n * 2048 + k * 1024); } while (0)
#define PG8_MMA(ai, bj, At, Bt) do { __builtin_amdgcn_s_setprio(1); _Pragma("unroll") for (int m = 0; m < 4; ++m) _Pragma("unroll") for (int n = 0; n < 2; ++n) _Pragma("unroll") for (int k = 0; k < 2; ++k) \
        acc[ai][bj][m][n] = __builtin_amdgcn_mfma_f32_16x16x32_bf16(Bt[n][k], At[m][k], acc[ai][bj][m][n], 0, 0, 0); __builtin_amdgcn_s_setprio(0); } while (0)
#define PG8_WAIT_V(n) asm volatile("s_waitcnt vmcnt(" #n ")" ::: "memory")
#define PG8_WAIT_L(n) asm volatile("s_waitcnt lgkmcnt(" #n ")" ::: "memory")
#define PG8_BAR __builtin_amdgcn_s_barrier()
#define PG8_SCHED __builtin_amdgcn_sched_barrier(0)
    Unit cur, nxt; int ui = 0;
    if (!S.next(0, cur)) return;
    f32x4 acc[2][2][4][2];
#pragma unroll
    for (int a = 0; a < 2; ++a)
#pragma unroll
        for (int b = 0; b < 2; ++b)
#pragma unroll
            for (int m = 0; m < 4; ++m)
#pragma unroll
                for (int n = 0; n < 2; ++n) acc[a][b][m][n] = (f32x4){0.f, 0.f, 0.f, 0.f};
    bf16x8 At[4][2], B0[2][2], B1[2][2];
    const char* cA = (const char*)g.A + (size_t)cur.pm * tstep; const char* cB = (const char*)g.Bt + (size_t)cur.pn * tstep;
    PG8_STAGE(PG8_SB(0, 0), cB, voffB); PG8_STAGE(PG8_SB(0, 1), cB + hstep, voffB); PG8_STAGE(PG8_SA(0, 0), cA, voffA); PG8_STAGE(PG8_SA(0, 1), cA + hstep, voffA);
    if (wr == 1) PG8_BAR;
    PG8_WAIT_V(2); PG8_BAR;
    PG8_STAGE(PG8_SB(1, 0), cB + kstep, voffB); PG8_STAGE(PG8_SA(1, 0), cA + kstep, voffA); PG8_STAGE(PG8_SB(1, 1), cB + hstep + kstep, voffB);
    PG8_WAIT_V(6); PG8_BAR;
    for (;;) {
        const bool has_next = S.next(ui + 1, nxt);
        const char* nA = has_next ? (const char*)g.A + (size_t)nxt.pm * tstep : cA; const char* nB = has_next ? (const char*)g.Bt + (size_t)nxt.pn * tstep : cB;
        for (int t = 0; t < nt; t += 2) {
            const bool last = (t == nt - 2);
            const char* a1 = cA + (size_t)(t + 1) * kstep;
            const char* a2 = last ? nA : cA + (size_t)(t + 2) * kstep; const char* b2 = last ? nB : cB + (size_t)(t + 2) * kstep;
            const char* a3 = a2 + kstep; const char* b3 = b2 + kstep;
            PG8_LDB(B0, 0, 0); PG8_LDB(B1, 0, 1); PG8_SCHED; PG8_LDA(At, 0, 0); PG8_STAGE(PG8_SA(1, 1), a1 + hstep, voffA);
            PG8_WAIT_V(8); PG8_WAIT_L(0); PG8_BAR; PG8_MMA(0, 0, At, B0); PG8_MMA(0, 1, At, B1); PG8_BAR; PG8_SCHED;
            PG8_LDA(At, 0, 1); PG8_STAGE(PG8_SB(0, 0), b2, voffB); PG8_STAGE(PG8_SB(0, 1), b2 + hstep, voffB); PG8_STAGE(PG8_SA(0, 0), a2, voffA);
            PG8_WAIT_V(8); PG8_WAIT_L(0); PG8_BAR; PG8_MMA(1, 0, At, B0); PG8_MMA(1, 1, At, B1); PG8_BAR; PG8_SCHED;
            PG8_LDB(B0, 1, 0); PG8_LDB(B1, 1, 1); PG8_SCHED; PG8_LDA(At, 1, 0); PG8_STAGE(PG8_SA(0, 1), a2 + hstep, voffA);
            PG8_WAIT_V(8); PG8_WAIT_L(0); PG8_BAR; PG8_MMA(0, 0, At, B0); PG8_MMA(0, 1, At, B1); PG8_BAR; PG8_SCHED;
            PG8_LDA(At, 1, 1); PG8_STAGE(PG8_SB(1, 0), b3, voffB); PG8_STAGE(PG8_SB(1, 1), b3 + hstep, voffB); PG8_STAGE(PG8_SA(1, 0), a3, voffA);
            PG8_WAIT_V(8); PG8_WAIT_L(0); PG8_BAR; PG8_MMA(1, 0, At, B0); PG8_MMA(1, 1, At, B1); PG8_BAR; PG8_SCHED;
        }
        if (wr == 0) PG8_BAR;
        E(acc, cur, wr, wc, fr, fq);
        if (!has_next) break;
#pragma unroll
        for (int a = 0; a < 2; ++a)
#pragma unroll
            for (int b = 0; b < 2; ++b)
#pragma unroll
                for (int m = 0; m < 4; ++m)
#pragma unroll
                    for (int n = 0; n < 2; ++n) acc[a][b][m][n] = (f32x4){0.f, 0.f, 0.f, 0.f};
        cur = nxt; cA = nA; cB = nB; ++ui;
        if (wr == 1) PG8_BAR;
    }
    PG8_WAIT_V(0);
    PG8_BAR;
#undef PG8_SA
#undef PG8_SB
#undef PG8_STAGE
#undef PG8_LDA
#undef PG8_LDB
#undef PG8_MMA
#undef PG8_WAIT_V
#undef PG8_WAIT_L
#undef PG8_BAR
#undef PG8_SCHED
}
}

struct EpiAll {
    int mode; bf16_t* O; int ldc; int sig_from; const bf16_t* G; float* T; bf16_t* Mout; const float* Xin; float* Xout; bf16_t* IKF;
    __device__ __forceinline__ void operator()(const f32x4 (&acc)[2][2][4][2], const pg8::Unit& u, int wr, int wc, int fr, int fq) const {
        const int row0 = u.pm * 256 + wr * 64 + fr, col0 = u.pn * 256 + wc * 32 + 8 * fq;
        if (mode == 0) {
            for (int dup_ = 0; dup_ < 1 + ((PROBE_DUP >> 7) & 1); ++dup_)
#pragma unroll
            for (int bj = 0; bj < 2; ++bj) {
                const bool sg = (u.pn * 2 + bj) >= sig_from;
                const int col = col0 + bj * 128;
#pragma unroll
                for (int ai = 0; ai < 2; ++ai)
#pragma unroll
                    for (int m = 0; m < 4; ++m) { const size_t row = (size_t)(row0 + ai * 128 + m * 16);
                        f32x4 v0 = acc[ai][bj][m][0], v1 = acc[ai][bj][m][1];
                        if (sg) {
#pragma unroll
                            for (int j = 0; j < 4; ++j) { v0[j] = sigmoidf_(v0[j]); v1[j] = sigmoidf_(v1[j]); } }
                        u32x4 w; w.x = cvt_pk_bf16(v0[0], v0[1]); w.y = cvt_pk_bf16(v0[2], v0[3]); w.z = cvt_pk_bf16(v1[0], v1[1]); w.w = cvt_pk_bf16(v1[2], v1[3]);
                        *(u32x4*)(O + row * ldc + col) = w;
                        if (col >= IK && col < IK + 64) {
                            const int kg = (col - IK) >> 3;
                            *(u32x4*)(IKF + ((row >> 5) * 4 + (kg >> 1)) * 512 + (((int)row & 31) + 32 * (kg & 1)) * 8) = w; }
                    }
            }
        } else if (mode <= 3) {
            u32x4 gw[2], tw[2], gn[2], tn[2], gm[2], tm[2];
#define EPI_LD(s_, G_, T_) do { const int bj_ = (s_) >> 2, ai_ = ((s_) >> 1) & 1, mb_ = ((s_) & 1) * 2; \
                _Pragma("unroll") for (int mm = 0; mm < 2; ++mm) { const size_t row = (size_t)(row0 + ai_ * 128 + (mb_ + mm) * 16); const int col = col0 + bj_ * 128; \
                    G_[mm] = *(const u32x4*)(G + row * NP + col); if (mode >= 2) T_[mm] = *(const u32x4*)(Mout + row * DM + col); } } while (0)
            EPI_LD(0, gw, tw); EPI_LD(1, gn, tn);
#pragma unroll
            for (int s = 0; s < 8; ++s) { const int bj = s >> 2, ai = (s >> 1) & 1, mb = (s & 1) * 2, col = col0 + bj * 128;
                if (s < 6) EPI_LD(s + 2, gm, tm);
                asm volatile("" ::: "memory");
#pragma unroll
                for (int mm = 0; mm < 2; ++mm) { const int m = mb + mm; const size_t row = (size_t)(row0 + ai * 128 + m * 16);
                    f32x4 v0 = acc[ai][bj][m][0], v1 = acc[ai][bj][m][1];
                    v0[0] *= bf_lo(gw[mm].x); v0[1] *= bf_hi(gw[mm].x); v0[2] *= bf_lo(gw[mm].y); v0[3] *= bf_hi(gw[mm].y);
                    v1[0] *= bf_lo(gw[mm].z); v1[1] *= bf_hi(gw[mm].z); v1[2] *= bf_lo(gw[mm].w); v1[3] *= bf_hi(gw[mm].w);
                    if (mode >= 2) { v0[0] += bf_lo(tw[mm].x); v0[1] += bf_hi(tw[mm].x); v0[2] += bf_lo(tw[mm].y); v0[3] += bf_hi(tw[mm].y);
                        v1[0] += bf_lo(tw[mm].z); v1[1] += bf_hi(tw[mm].z); v1[2] += bf_lo(tw[mm].w); v1[3] += bf_hi(tw[mm].w); }
                    u32x4 w; w.x = cvt_pk_bf16(v0[0], v0[1]); w.y = cvt_pk_bf16(v0[2], v0[3]); w.z = cvt_pk_bf16(v1[0], v1[1]); w.w = cvt_pk_bf16(v1[2], v1[3]);
                    *(u32x4*)(Mout + row * DM + col) = w; }
                asm volatile("" ::: "memory");
#pragma unroll
                for (int mm = 0; mm < 2; ++mm) { gw[mm] = gn[mm]; tw[mm] = tn[mm]; gn[mm] = gm[mm]; tn[mm] = tm[mm]; }
            }
#undef EPI_LD
        } else {
            f32x4 xa[2], xb[2], xan[2], xbn[2];
#define EPI_LD(s_, A_, B_) do { const int bj_ = (s_) >> 2, ai_ = ((s_) >> 1) & 1, mb_ = ((s_) & 1) * 2; \
                _Pragma("unroll") for (int mm = 0; mm < 2; ++mm) { const size_t o = (size_t)(row0 + ai_ * 128 + (mb_ + mm) * 16) * DM + col0 + bj_ * 128; \
                    A_[mm] = *(const f32x4*)(Xin + o); B_[mm] = *(const f32x4*)(Xin + o + 4); } } while (0)
            EPI_LD(0, xa, xb);
#pragma unroll
            for (int s = 0; s < 8; ++s) { const int bj = s >> 2, ai = (s >> 1) & 1, mb = (s & 1) * 2;
                if (s < 7) EPI_LD(s + 1, xan, xbn);
                asm volatile("" ::: "memory");
#pragma unroll
                for (int mm = 0; mm < 2; ++mm) { const size_t o = (size_t)(row0 + ai * 128 + (mb + mm) * 16) * DM + col0 + bj * 128;
                    *(f32x4*)(Xout + o) = xa[mm] + acc[ai][bj][mb + mm][0]; *(f32x4*)(Xout + o + 4) = xb[mm] + acc[ai][bj][mb + mm][1]; }
                asm volatile("" ::: "memory");
#pragma unroll
                for (int mm = 0; mm < 2; ++mm) { xa[mm] = xan[mm]; xb[mm] = xbn[mm]; }
            }
#undef EPI_LD
        }
    }
};

__device__ __forceinline__ void tcvt_load(const float* __restrict__ src, int ld_src, int k0, int n0, int mode, f32x4 (&v)[2]) {
    const int tid = otid();
#pragma unroll
    for (int i = 0; i < 2; ++i) {
        const int idx = tid + 512 * i, kk = idx >> 4, nq = idx & 15, n = n0 + 4 * nq;
        int sc = n; bool valid = true;
        if (mode == 1) { if (n < 12368) sc = n; else if (n < 12416) valid = false; else if (n < 18560) sc = n - 48; else valid = false; }
        v[i] = (f32x4){0.f, 0.f, 0.f, 0.f};
        if (valid) v[i] = *(const f32x4*)(src + (size_t)(k0 + kk) * ld_src + sc);
    }
}
__device__ __forceinline__ void tcvt_lds_write(const f32x4 (&v)[2], float* tile) {
    const int tid = otid();
#pragma unroll
    for (int i = 0; i < 2; ++i) { const int idx = tid + 512 * i, kk = idx >> 4, nq = idx & 15;
        float* tp = tile + kk * 65 + 4 * nq; tp[0] = v[i][0]; tp[1] = v[i][1]; tp[2] = v[i][2]; tp[3] = v[i][3]; }
}
__device__ __forceinline__ void tcvt_store(bf16_t* __restrict__ dst, int K, int k0, int n0, const float* tile) {
    const int tid = otid();
    const int n = tid >> 3, kc = tid & 7; const float* tp = tile + (kc * 8) * 65 + n;
    u32x4 w; w.x = cvt_pk_bf16(tp[0], tp[65]); w.y = cvt_pk_bf16(tp[130], tp[195]); w.z = cvt_pk_bf16(tp[260], tp[325]); w.w = cvt_pk_bf16(tp[390], tp[455]);
    *(u32x4*)(dst + (size_t)(n0 + n) * K + k0 + kc * 8) = w;
}

__device__ __forceinline__ void rmsnorm_rows(const float* __restrict__ X, const float* __restrict__ g, bf16_t* __restrict__ H, float* __restrict__ Out) {
    const int lane = otid() & 63, gw = blockIdx.x * 8 + (otid() >> 6), nw = gridDim.x * 8;
    for (int row = gw; row < MT; row += nw) {
        const f32x4* xr = (const f32x4*)(X + (size_t)row * DM);
        f32x4 v[8]; float ss = 0.f;
#pragma unroll
        for (int i = 0; i < 8; ++i) { v[i] = xr[lane + 64 * i]; ss += v[i][0] * v[i][0] + v[i][1] * v[i][1] + v[i][2] * v[i][2] + v[i][3] * v[i][3]; }
#pragma unroll
        for (int o = 32; o >= 1; o >>= 1) ss += __shfl_xor(ss, o);
        const float rstd = rsqrtf(ss * (1.0f / DM) + 1e-6f);
#pragma unroll
        for (int i = 0; i < 8; ++i) { const f32x4 gg = *(const f32x4*)(g + 4 * (lane + 64 * i));
            const float a = v[i][0] * rstd * gg[0], b = v[i][1] * rstd * gg[1], c = v[i][2] * rstd * gg[2], d = v[i][3] * rstd * gg[3];
            if (H) { u32x2 w; w.x = cvt_pk_bf16(a, b); w.y = cvt_pk_bf16(c, d); *(u32x2*)(H + (size_t)row * DM + 4 * (lane + 64 * i)) = w; }
            else { *(f32x4*)(Out + (size_t)row * DM + 4 * (lane + 64 * i)) = (f32x4){a, b, c, d}; } }
    }
}

__device__ __forceinline__ void convert_layer(const Params& p, float* tile, int l, int bid, int nb) {
    int base = 0;
    for (int kind = 0; kind < 5; ++kind) {
        const float* src; bf16_t* dst; int ld_src, K, ntn, mode = 0;
        if (kind == 0) { src = p.w_in + (size_t)l * DM * INC; dst = (bf16_t*)(p.ws + WS_WTIN + SZ_WTIN1 * l); ld_src = INC; K = DM; ntn = NP / 64; mode = 1; }
        else if (kind == 4) { src = p.w_o + (size_t)l * DM * DM; dst = (bf16_t*)(p.ws + WS_WTO + SZ_WTO1 * l); ld_src = DM; K = DM; ntn = DM / 64; }
        else { const float* s3 = kind == 1 ? p.p_a : (kind == 2 ? p.p_b : p.p_c); const size_t o3 = kind == 1 ? WS_WTPA : (kind == 2 ? WS_WTPB : WS_WTPC);
            src = s3 + (size_t)l * 1024 * DM; dst = (bf16_t*)(p.ws + o3 + SZ_WTP1 * l); ld_src = DM; K = 1024; ntn = DM / 64; }
        const int cnt = ntn * (K / 64);
        int first = (bid - base) % nb; if (first < 0) first += nb;
        f32x4 v[2];
        if (first < cnt) tcvt_load(src, ld_src, (first / ntn) * 64, (first % ntn) * 64, mode, v);
        for (int j = first; j < cnt; j += nb) {
            const int kt = j / ntn, nt = j % ntn;
            tcvt_lds_write(v, tile);
            __syncthreads();
            if (j + nb < cnt) tcvt_load(src, ld_src, ((j + nb) / ntn) * 64, ((j + nb) % ntn) * 64, mode, v);
            tcvt_store(dst, K, kt * 64, nt * 64, tile);
            __syncthreads();
        }
        base += cnt;
    }
}

__device__ __forceinline__ void phase_prep(const Params& p, unsigned char* smem) {
    float* tile = (float*)smem;
    const int bid = blockIdx.x, nb = gridDim.x;
    convert_layer(p, tile, 0, bid, nb);
    { bf16_t* aw = (bf16_t*)(p.ws + WS_AWS); const int n = DEPTH * 8 * 128 * 128;
      for (int i = bid * 512 + otid(); i < n; i += nb * 512) { const int s = i & 127, t = (i >> 7) & 127; const float v = (s <= t) ? p.a_ws[i] : 0.f; aw[i] = (bf16_t)(cvt_pk_bf16(v, 0.f) & 0xffffu); } }
    rmsnorm_rows(p.x, p.norm_g, (bf16_t*)(p.ws + WS_H), nullptr);
}

__device__ __forceinline__ void isel_item(const Params& p, int item, unsigned char* smem) {
    const bf16_t* P = (const bf16_t*)(p.ws + WS_P); unsigned long long* MK = (unsigned long long*)(p.ws + WS_MASK);
    unsigned* SU = (unsigned*)smem;
    const int tid = otid(), lane = tid & 63, w = __builtin_amdgcn_readfirstlane(tid >> 6), hh = lane >> 5, l31 = lane & 31;
    const int b = item >> 9, t0 = (((item >> 8) & 1) ? 511 - (item & 255) : (item & 255)) * 8;
    const int nkt = ((t0 + 7) >> 5) + 1;
    {
        bf16x8 Af[4][4]; float wv[4][16];
        const int qq = (l31 >> 2) & 1, hd = (l31 & 3) + 4 * (l31 >> 3);
#pragma unroll
        for (int rt = 0; rt < 4; ++rt) { const bf16_t* bp = P + (size_t)(b * SL + t0 + 2 * rt + qq) * NP + IQ + hd * 64 + hh * 8;
#pragma unroll
            for (int ks = 0; ks < 4; ++ks) Af[rt][ks] = *(const bf16x8*)(bp + ks * 16);
            const u32x4* wp = (const u32x4*)(P + (size_t)(b * SL + t0 + 2 * rt + hh) * NP + IW);
            const u32x4 w0 = wp[0], w1 = wp[1];
            const float sc = 1.0f / 32.0f;
            wv[rt][0] = bf_lo(w0.x) * sc; wv[rt][1] = bf_hi(w0.x) * sc; wv[rt][2] = bf_lo(w0.y) * sc; wv[rt][3] = bf_hi(w0.y) * sc;
            wv[rt][4] = bf_lo(w0.z) * sc; wv[rt][5] = bf_hi(w0.z) * sc; wv[rt][6] = bf_lo(w0.w) * sc; wv[rt][7] = bf_hi(w0.w) * sc;
            wv[rt][8] = bf_lo(w1.x) * sc; wv[rt][9] = bf_hi(w1.x) * sc; wv[rt][10] = bf_lo(w1.y) * sc; wv[rt][11] = bf_hi(w1.y) * sc;
            wv[rt][12] = bf_lo(w1.z) * sc; wv[rt][13] = bf_hi(w1.z) * sc; wv[rt][14] = bf_lo(w1.w) * sc; wv[rt][15] = bf_hi(w1.w) * sc; }
        const bf16_t* kb = (const bf16_t*)(p.ws + WS_IKF) + (size_t)(b * (SL / 32)) * 2048 + lane * 8;
        bf16x8 Bf[4];
        if (w < nkt) {
#pragma unroll
            for (int ks = 0; ks < 4; ++ks) Bf[ks] = *(const bf16x8*)(kb + (size_t)w * 2048 + ks * 512);
        }
        for (int j = w; j < nkt; j += 8) {
            f32x16 acc[4];
#pragma unroll
            for (int rt = 0; rt < 4; ++rt) acc[rt] = (f32x16){};
#pragma unroll
            for (int ks = 0; ks < 4; ++ks)
#pragma unroll
                for (int rt = 0; rt < 4; ++rt) acc[rt] = __builtin_amdgcn_mfma_f32_32x32x16_bf16(Af[rt][ks], Bf[ks], acc[rt], 0, 0, 0);
            if (j + 8 < nkt) {
#pragma unroll
                for (int ks = 0; ks < 4; ++ks) Bf[ks] = *(const bf16x8*)(kb + (size_t)(j + 8) * 2048 + ks * 512);
            }
            const int key = 32 * j + l31;
#pragma unroll
            for (int rt = 0; rt < 4; ++rt) {
                float sv = 0.f;
#pragma unroll
                for (int q = 0; q < 16; ++q) sv += wv[rt][q] * fmaxf(acc[rt][q], 0.f);
                const int qi = 2 * rt + hh;
                const unsigned bits = __float_as_uint(sv);
                const unsigned uu = bits ^ ((bits >> 31) ? 0xffffffffu : 0x80000000u);
                SU[qi * 4096 + key] = (key <= t0 + qi) ? uu : 0u;
            }
        }
    }
    __syncthreads();
    {
        const int t = t0 + w, njw = (t >> 6) + 1, q = b * SL + t;
        const unsigned* row = SU + w * 4096;
        unsigned u[64];
#pragma unroll
        for (int jb = 0; jb < 8; ++jb) {
            if (jb * 8 < njw) {
#pragma unroll
                for (int jj = 0; jj < 8; ++jj) { const int j = jb * 8 + jj, key = 64 * j + lane; u[j] = (key <= t) ? row[key] : 0u; }
            } else {
#pragma unroll
                for (int jj = 0; jj < 8; ++jj) u[jb * 8 + jj] = 0;
            }
        }
        unsigned T = 1u; bool exact = true; int need = 0;
        if (t >= 256) {
            unsigned* hist = SU + w * 4096;
#pragma unroll
            for (int i = 0; i < 16; ++i) *(u32x4*)(hist + 4 * (lane + 64 * i)) = (u32x4){0u, 0u, 0u, 0u};
            asm volatile("" ::: "memory");
#pragma unroll
            for (int jb = 0; jb < 8; ++jb) if (jb * 8 < njw) {
#pragma unroll
                for (int jj = 0; jj < 8; ++jj) { const unsigned v = u[jb * 8 + jj];
                    __hip_atomic_fetch_add(hist + (v ? (v >> 20) : (unsigned)lane), 1u, __ATOMIC_RELAXED, __HIP_MEMORY_SCOPE_WORKGROUP); } }
            asm volatile("" ::: "memory");
            int sl = 0;
#pragma unroll
            for (int i = 0; i < 16; ++i) { const u32x4 h4 = *(const u32x4*)(hist + 64 * lane + 4 * i); sl += (int)(h4.x + h4.y + h4.z + h4.w); }
            int suf = sl;
#pragma unroll
            for (int o = 1; o < 64; o <<= 1) { const int v = __shfl_down(suf, o); if (lane + o < 64) suf += v; }
            const unsigned long long okm = __ballot(suf >= 256);
            const int Lh = 63 - __clzll(okm);
            const int sufL = __shfl(suf, Lh), slL = __shfl(sl, Lh);
            const int above = sufL - slL;
            int hs = (int)hist[64 * Lh + lane];
#pragma unroll
            for (int o = 1; o < 64; o <<= 1) { const int v = __shfl_down(hs, o); if (lane + o < 64) hs += v; }
            const unsigned long long okb = __ballot(hs + above >= 256);
            const int Ib = 63 - __clzll(okb);
            T = (unsigned)(64 * Lh + Ib) << 20; exact = false;
            for (int bit = 19; bit >= 0; --bit) {
                const unsigned cand = T | (1u << bit); int cl = 0;
#pragma unroll
                for (int jb = 0; jb < 8; ++jb) if (jb * 8 < njw) {
#pragma unroll
                    for (int jj = 0; jj < 8; ++jj) cl += (u[jb * 8 + jj] >= cand) ? 1 : 0; }
                int cnt = 0;
#pragma unroll
                for (int bb = 0; bb < 7; ++bb) cnt += __popcll(__ballot((cl >> bb) & 1)) << bb;
                if (cnt >= 256) { T = cand; if (cnt == 256) { exact = true; break; } }
            }
            if (!exact) { int cgt = 0;
#pragma unroll
                for (int j = 0; j < 64; ++j) cgt += __popcll(__ballot(u[j] > T));
                need = 256 - cgt; }
        }
        unsigned long long myw = 0;
        if (exact) {
#pragma unroll
            for (int j = 0; j < 64; ++j) { const unsigned long long m = __ballot(u[j] >= T); if (lane == j) myw = m; }
        } else {
#pragma unroll
            for (int j = 0; j < 64; ++j) {
                const unsigned long long gt = __ballot(u[j] > T); unsigned long long eq = __ballot(u[j] == T);
                while (__popcll(eq) > need) eq &= ~(1ull << (63 - __clzll(eq)));
                need -= __popcll(eq);
                const unsigned long long m = gt | eq; if (lane == j) myw = m; }
        }
        MK[(size_t)q * 64 + lane] = myw;
    }
    __syncthreads();
}

__device__ __forceinline__ void sgu_item(const Params& p, int layer, int item, unsigned char* smem) {
    const bf16_t* P = (const bf16_t*)(p.ws + WS_P); bf16_t* YA = (bf16_t*)(p.ws + WS_YA);
    const bf16_t* aws = (const bf16_t*)(p.ws + WS_AWS + SZ_AWS1 * layer);
    const int tid = otid(), lane = tid & 63, w = tid >> 6, hh = lane >> 5, l31 = lane & 31;
    const int b = item >> 8, n = (item >> 3) & 31, g = item & 7, tok0 = b * SL + n * 128;
#pragma unroll
    for (int i = 0; i < 4; ++i) { const int ch = tid + 512 * i, c8 = ch >> 7, s = ch & 127;
        const u32x4 v = *(const u32x4*)(P + (size_t)(tok0 + s) * NP + AV + g * 128 + c8 * 8);
        unsigned char* d = smem + (c8 * 8) * 272 + s * 2;
        *(bf16_t*)(d + 0 * 272) = (bf16_t)(v.x & 0xffff); *(bf16_t*)(d + 1 * 272) = (bf16_t)(v.x >> 16);
        *(bf16_t*)(d + 2 * 272) = (bf16_t)(v.y & 0xffff); *(bf16_t*)(d + 3 * 272) = (bf16_t)(v.y >> 16);
        *(bf16_t*)(d + 4 * 272) = (bf16_t)(v.z & 0xffff); *(bf16_t*)(d + 5 * 272) = (bf16_t)(v.z >> 16);
        *(bf16_t*)(d + 6 * 272) = (bf16_t)(v.w & 0xffff); *(bf16_t*)(d + 7 * 272) = (bf16_t)(v.w >> 16); }
    __syncthreads();
    const int tt = w & 3, cp = w >> 2, t = 32 * tt + l31, tok = tok0 + t;
    const float bias = p.a_b[(size_t)(layer * 8 + g) * 128 + t];
    const bf16_t* wsrow = aws + ((size_t)g * 128 + t) * 128 + hh * 8;
#pragma unroll
    for (int ci = 0; ci < 2; ++ci) {
        const int ct = cp * 2 + ci;
        f32x16 acc = {};
        for (int ks = 0; ks < 2 * (tt + 1); ++ks) {
            const bf16x8 A = *(const bf16x8*)(smem + (32 * ct + l31) * 272 + (ks * 16 + hh * 8) * 2);
            const bf16x8 Bv = *(const bf16x8*)(wsrow + ks * 16);
            acc = __builtin_amdgcn_mfma_f32_32x32x16_bf16(A, Bv, acc, 0, 0, 0);
        }
#pragma unroll
        for (int q4 = 0; q4 < 4; ++q4) {
            const int c = g * 128 + 32 * ct + 8 * q4 + 4 * hh;
            const u32x2 u4 = *(const u32x2*)(P + (size_t)tok * NP + AU + c), z4 = *(const u32x2*)(P + (size_t)tok * NP + AZ + c);
            const float y0 = bf_lo(u4.x) * (acc[4 * q4 + 0] + bias) * siluf_(bf_lo(z4.x));
            const float y1 = bf_hi(u4.x) * (acc[4 * q4 + 1] + bias) * siluf_(bf_hi(z4.x));
            const float y2 = bf_lo(u4.y) * (acc[4 * q4 + 2] + bias) * siluf_(bf_lo(z4.y));
            const float y3 = bf_hi(u4.y) * (acc[4 * q4 + 3] + bias) * siluf_(bf_hi(z4.y));
            u32x2 o; o.x = cvt_pk_bf16(y0, y1); o.y = cvt_pk_bf16(y2, y3);
            *(u32x2*)(YA + (size_t)tok * 1024 + c) = o;
        }
    }
    __syncthreads();
}

__device__ __forceinline__ void vt_item(const Params& p, int item, unsigned char* smem) {
    const bf16_t* P = (const bf16_t*)(p.ws + WS_P); bf16_t* VT = (bf16_t*)(p.ws + WS_VT);
    const int tid = otid();
    const int b = item >> 9, h = (item >> 6) & 7, st = item & 63;
#pragma unroll
    for (int i = 0; i < 2; ++i) { const int ch = tid + 512 * i, d8 = ch >> 6, s = ch & 63;
        const u32x4 v = *(const u32x4*)(P + (size_t)(b * SL + st * 64 + s) * NP + CV + h * 128 + d8 * 8);
        unsigned char* d = smem + (d8 * 8) * 144 + s * 2;
        *(bf16_t*)(d + 0 * 144) = (bf16_t)(v.x & 0xffff); *(bf16_t*)(d + 1 * 144) = (bf16_t)(v.x >> 16);
        *(bf16_t*)(d + 2 * 144) = (bf16_t)(v.y & 0xffff); *(bf16_t*)(d + 3 * 144) = (bf16_t)(v.y >> 16);
        *(bf16_t*)(d + 4 * 144) = (bf16_t)(v.z & 0xffff); *(bf16_t*)(d + 5 * 144) = (bf16_t)(v.z >> 16);
        *(bf16_t*)(d + 6 * 144) = (bf16_t)(v.w & 0xffff); *(bf16_t*)(d + 7 * 144) = (bf16_t)(v.w >> 16); }
    __syncthreads();
#pragma unroll
    for (int i = 0; i < 2; ++i) { const int ch = tid + 512 * i, d = ch >> 3, c16 = ch & 7;
        const u32x4 v = *(const u32x4*)(smem + d * 144 + c16 * 16);
        *(u32x4*)(VT + ((size_t)((b * 8 + h) * 128 + d)) * SL + st * 64 + c16 * 8) = v; }
    __syncthreads();
}

__device__ __forceinline__ void conv_item(const Params& p, int layer, int item) {
    const bf16_t* P = (const bf16_t*)(p.ws + WS_P); bf16_t* YB = (bf16_t*)(p.ws + WS_YB);
    const float* cw = p.b_conv + (size_t)layer * 3 * 1024;
    const int tid = otid();
#pragma unroll
    for (int i = 0; i < 4; ++i) {
        const int idx = tid + 512 * i, tk = idx >> 7, c = (idx & 127) * 8, tok = item * 16 + tk, tpos = tok & (SL - 1);
        const bf16_t* row = P + (size_t)tok * NP;
        const u32x4 bg = *(const u32x4*)(row + BB + c), zz = *(const u32x4*)(row + BZ + c);
        const u32x4 c0 = *(const u32x4*)(row + BC + c), x0 = *(const u32x4*)(row + BX + c);
        u32x4 c1 = (u32x4){0, 0, 0, 0}, x1 = c1, c2 = c1, x2 = c1;
        if (tpos >= 1) { c1 = *(const u32x4*)(row - NP + BC + c); x1 = *(const u32x4*)(row - NP + BX + c); }
        if (tpos >= 2) { c2 = *(const u32x4*)(row - 2 * NP + BC + c); x2 = *(const u32x4*)(row - 2 * NP + BX + c); }
        float y[8];
#pragma unroll
        for (int e = 0; e < 8; ++e) {
            const int wi = e >> 1; const bool hi = e & 1;
            const unsigned bgw = bg[wi], zw = zz[wi], c0w = c0[wi], x0w = x0[wi], c1w = c1[wi], x1w = x1[wi], c2w = c2[wi], x2w = x2[wi];
            const float fb = hi ? bf_hi(bgw) : bf_lo(bgw), fz = hi ? bf_hi(zw) : bf_lo(zw);
            const float a0 = (hi ? bf_hi(c0w) : bf_lo(c0w)) * (hi ? bf_hi(x0w) : bf_lo(x0w));
            const float a1 = (hi ? bf_hi(c1w) : bf_lo(c1w)) * (hi ? bf_hi(x1w) : bf_lo(x1w));
            const float a2 = (hi ? bf_hi(c2w) : bf_lo(c2w)) * (hi ? bf_hi(x2w) : bf_lo(x2w));
            const float cv = cw[2048 + c + e] * a0 + cw[1024 + c + e] * a1 + cw[c + e] * a2;
            y[e] = fb * cv * siluf_(fz);
        }
        u32x4 o; o.x = cvt_pk_bf16(y[0], y[1]); o.y = cvt_pk_bf16(y[2], y[3]); o.z = cvt_pk_bf16(y[4], y[5]); o.w = cvt_pk_bf16(y[6], y[7]);
        *(u32x4*)(YB + (size_t)tok * 1024 + c) = o;
    }
}

__device__ __forceinline__ void phase_mixprep(const Params& p, int layer, unsigned char* smem) {
    constexpr int nI = 2048, nA = 1024, nV = 2048, nC = 1024;
    for (int j = blockIdx.x; j < nI + nA + nV + nC; j += gridDim.x) {
        if (j < nI) { for (int d = 0; d < 1 + ((PROBE_MIX >> 0) & 1); ++d) isel_item(p, j, smem); }
        else if (j < nI + nA) { for (int d = 0; d < 1 + ((PROBE_MIX >> 1) & 1); ++d) sgu_item(p, layer, j - nI, smem); }
        else if (j < nI + nA + nV) { for (int d = 0; d < 1 + ((PROBE_MIX >> 2) & 1); ++d) vt_item(p, j - nI - nA, smem); }
        else { for (int d = 0; d < 1 + ((PROBE_MIX >> 3) & 1); ++d) conv_item(p, layer, j - nI - nA - nV); }
    }
}

__device__ __forceinline__ int swap23(int i) { return (i & ~12) | ((i & 4) << 1) | ((i & 8) >> 1); }

__device__ __forceinline__ void phase_attn(const Params& p, unsigned char* smem) {
    const bf16_t* P = (const bf16_t*)(p.ws + WS_P); const bf16_t* VT = (const bf16_t*)(p.ws + WS_VT); bf16_t* YC = (bf16_t*)(p.ws + WS_YC);
    const unsigned long long* MK = (const unsigned long long*)(p.ws + WS_MASK);
    const int tid = otid(), lane = tid & 63, w = __builtin_amdgcn_readfirstlane(tid >> 6), hh = lane >> 5, l31 = lane & 31;
    constexpr int STG = 32768, KOFF = 0, VOFF = 16384;
    LAS unsigned char* lds = (LAS unsigned char*)smem;
    float* biasL = (float*)(smem + 3 * STG);
    constexpr float LOG2E = 1.4426950408889634f;
    const float sc = 0.08838834764831845f * LOG2E;
    int kro[2], vro[4];
#pragma unroll
    for (int c2 = 0; c2 < 2; ++c2) kro[c2] = (32 * c2 + swap23(l31)) * 256;
    const int krx = swap23(l31) & 15;
    const int vrx = (l31 >> 1) & 7;
#define ATT_WAIT_V(n) asm volatile("s_waitcnt vmcnt(" #n ")" ::: "memory")
#define ATT_ISSUE(kt_, stg_) do { const char* kg_ = (const char*)Kg + (size_t)(kt_) * 64 * NP * 2; const char* vg_ = (const char*)Vg + (size_t)(kt_) * 128; \
        int li_ = lane; asm volatile("" : "+v"(li_)); \
        _Pragma("unroll") for (int i_ = 0; i_ < 2; ++i_) { const int n_ = w + 8 * i_; \
            const int kr_ = 4 * n_ + (li_ >> 4), kc_ = (li_ & 15) ^ (kr_ & 15); const unsigned kgo_ = (unsigned)(kr_ * NP * 2 + kc_ * 16); \
            const int vd_ = 8 * n_ + (li_ >> 3), vc_ = (li_ & 7) ^ ((vd_ >> 1) & 7); const unsigned vgo_ = (unsigned)(vd_ * SL * 2 + vc_ * 16); \
            __builtin_amdgcn_global_load_lds((const unsigned*)(kg_ + kgo_), (LAS unsigned*)(lds + (stg_) * STG + KOFF + n_ * 1024), 16, 0, 0); \
            __builtin_amdgcn_global_load_lds((const unsigned*)(vg_ + vgo_), (LAS unsigned*)(lds + (stg_) * STG + VOFF + n_ * 1024), 16, 0, 0); } } while (0)
    for (int item = blockIdx.x; item < 256; item += gridDim.x) {
        const int bh = (item & 7) + 8 * (item >> 6), pr = (item >> 3) & 7, b = bh >> 3, h = bh & 7;
        __syncthreads();
        if (tid < 129) { int bk = tid; if (tid >= 16) { bk = 16 + (int)(logf((float)tid * 0.0625f) / 2.0794415416798357f * 16.0f); bk = bk > 31 ? 31 : bk; } if (tid >= 128) bk = 31;
            biasL[tid] = (p.rel_bias[bk * 8 + h] - p.rel_bias[31 * 8 + h]) * LOG2E; }
        __syncthreads();
        const bf16_t* Kg = P + (size_t)(b * SL) * NP + CK + h * 128;
        const bf16_t* Vg = VT + (size_t)((b * 8 + h) * 128) * SL;
        for (int si = 0; si < 2; ++si) {
            const int qt = si ? pr : 15 - pr, q0 = qt * 256, tq = q0 + 32 * w + l31, tokq = b * SL + tq;
            const int nkt = (q0 + 256) >> 6, wlast = (q0 + 32 * w + 31) >> 6;
            bf16x8 Qf[8];
#pragma unroll
            for (int ks = 0; ks < 8; ++ks) { const u32x4 q4 = *(const u32x4*)(P + (size_t)tokq * NP + CQ + h * 128 + ks * 16 + hh * 8);
                u32x4 qs; qs.x = cvt_pk_bf16(bf_lo(q4.x) * sc, bf_hi(q4.x) * sc); qs.y = cvt_pk_bf16(bf_lo(q4.y) * sc, bf_hi(q4.y) * sc);
                qs.z = cvt_pk_bf16(bf_lo(q4.z) * sc, bf_hi(q4.z) * sc); qs.w = cvt_pk_bf16(bf_lo(q4.w) * sc, bf_hi(q4.w) * sc);
                __builtin_memcpy(&Qf[ks], &qs, 16); }
            const unsigned long long* mrow = MK + (size_t)tokq * 64;
            unsigned long long mnext = mrow[0];
            ATT_WAIT_V(0);
            ATT_ISSUE(0, 0);
            ATT_ISSUE(1, 1);
            f32x16 O[4];
#pragma unroll
            for (int dt = 0; dt < 4; ++dt) O[dt] = (f32x16){};
            float mrun = -1e30f, lsum = 0.f;
            int stg = 0;
            for (int kt = 0; kt < nkt; ++kt) {
                ATT_WAIT_V(4);
                __builtin_amdgcn_s_barrier();
                const unsigned long long mw = mnext;
                if (kt + 1 <= wlast) mnext = mrow[kt + 1];
                { const int k2 = (kt + 2 < nkt) ? kt + 2 : nkt - 1; const int s2 = (stg + 2 >= 3) ? stg - 1 : stg + 2; ATT_ISSUE(k2, s2); }
                if (kt <= wlast) {
                    LAS const unsigned char* Kc = lds + stg * STG + KOFF; LAS const unsigned char* Vc = lds + stg * STG + VOFF;
                    f32x16 sa[2];
#pragma unroll
                    for (int c2 = 0; c2 < 2; ++c2) {
                        sa[c2] = (f32x16){};
#pragma unroll
                        for (int ks = 0; ks < 8; ++ks) sa[c2] = __builtin_amdgcn_mfma_f32_32x32x16_bf16(*(LAS const bf16x8*)(Kc + kro[c2] + (((2 * ks + hh) ^ krx) << 4)), Qf[ks], sa[c2], 0, 0, 0);
                    }
                    const bool far = ((q0 + 32 * w) - (64 * kt + 63)) >= 128;
                    const int dist0 = tq - (64 * kt + 8 * hh);
                    const unsigned mlo = ((unsigned)mw) >> (8 * hh), mhi = ((unsigned)(mw >> 32)) >> (8 * hh);
                    if (!far) {
#pragma unroll
                        for (int c2 = 0; c2 < 2; ++c2)
#pragma unroll
                            for (int r = 0; r < 16; ++r) { int d = dist0 - (32 * c2 + 16 * (r >> 3) + (r & 7)); d = d < 0 ? 0 : (d > 128 ? 128 : d); sa[c2][r] += biasL[d]; }
                    }
                    float mx = fmaxf(sa[0][0], sa[1][0]);
#pragma unroll
                    for (int r = 1; r < 16; ++r) mx = fmaxf(fmaxf(mx, sa[0][r]), sa[1][r]);
                    mx = fmaxf(mx, __shfl_xor(mx, 32));
                    float alpha = 1.0f;
                    const bool grow = __ballot(mx > mrun + 8.0f) != 0ull;
                    if (grow) { const float mnew_ = fmaxf(mrun, mx); alpha = fast_exp2(mrun - mnew_); mrun = mnew_; }
                    const float mnew = mrun;
                    float ps = 0.f;
#pragma unroll
                    for (int c2 = 0; c2 < 2; ++c2)
#pragma unroll
                        for (int r = 0; r < 16; ++r) {
                            const int e = __builtin_amdgcn_sbfe((int)(c2 ? mhi : mlo), 16 * (r >> 3) + (r & 7), 1);
                            const float pv = __uint_as_float(__float_as_uint(fast_exp2(sa[c2][r] - mnew)) & (unsigned)e);
                            sa[c2][r] = pv; ps += pv; }
                    lsum = lsum * alpha + ps;
                    if (grow) {
#pragma unroll
                        for (int dt = 0; dt < 4; ++dt) O[dt] *= alpha;
                    }
#pragma unroll
                    for (int c2 = 0; c2 < 2; ++c2)
#pragma unroll
                        for (int c = 0; c < 2; ++c) {
                            u32x4 pw; pw.x = cvt_pk_bf16(sa[c2][8 * c + 0], sa[c2][8 * c + 1]); pw.y = cvt_pk_bf16(sa[c2][8 * c + 2], sa[c2][8 * c + 3]);
                            pw.z = cvt_pk_bf16(sa[c2][8 * c + 4], sa[c2][8 * c + 5]); pw.w = cvt_pk_bf16(sa[c2][8 * c + 6], sa[c2][8 * c + 7]);
                            bf16x8 Pf; __builtin_memcpy(&Pf, &pw, 16);
                            const int vch = ((4 * c2 + 2 * c + hh) ^ vrx) << 4;
#pragma unroll
                            for (int dt = 0; dt < 4; ++dt) O[dt] = __builtin_amdgcn_mfma_f32_32x32x16_bf16(*(LAS const bf16x8*)(Vc + (32 * dt + l31) * 128 + vch), Pf, O[dt], 0, 0, 0);
                        }
                }
                stg = (stg == 2) ? 0 : stg + 1;
            }
            ATT_WAIT_V(0);
            __builtin_amdgcn_s_barrier();
            lsum += __shfl_xor(lsum, 32);
            const float inv = 1.0f / lsum;
#pragma unroll
            for (int dt = 0; dt < 4; ++dt)
#pragma unroll
                for (int q4 = 0; q4 < 4; ++q4) {
                    const int d = h * 128 + 32 * dt + 8 * q4 + 4 * hh;
                    const u32x2 z4 = *(const u32x2*)(P + (size_t)tokq * NP + CZ + d);
                    const float y0 = O[dt][4 * q4 + 0] * inv * siluf_(bf_lo(z4.x)), y1 = O[dt][4 * q4 + 1] * inv * siluf_(bf_hi(z4.x));
                    const float y2 = O[dt][4 * q4 + 2] * inv * siluf_(bf_lo(z4.y)), y3 = O[dt][4 * q4 + 3] * inv * siluf_(bf_hi(z4.y));
                    u32x2 o; o.x = cvt_pk_bf16(y0, y1); o.y = cvt_pk_bf16(y2, y3);
                    *(u32x2*)(YC + (size_t)tokq * 1024 + d) = o;
                }
        }
    }
#undef ATT_WAIT_V
#undef ATT_ISSUE
}

#define XB_TMO      128
#define XB_XCNT(j)  (256  + 64 * (j))
#define XB_XSUB(j)  (1280 + 64 * (j))
#define XB_XGEN(j)  (2304 + 64 * (j))
#define XB_TOP      3328
#define XB_TOPGEN   3392
#define XCD_BAR_WORDS 3456
#define XB_SPIN_CAP (1u << 18)
__device__ __forceinline__ unsigned xb_ld(unsigned* p)              { return __hip_atomic_load(p, __ATOMIC_RELAXED, __HIP_MEMORY_SCOPE_AGENT); }
__device__ __forceinline__ unsigned xb_add(unsigned* p, unsigned v) { return __hip_atomic_fetch_add(p, v, __ATOMIC_RELAXED, __HIP_MEMORY_SCOPE_AGENT); }
__device__ __forceinline__ unsigned xb_xcc_id() { return (unsigned)__builtin_amdgcn_s_getreg((3 << 11) | 20) & 0xFu; }
#define XB_SPIN(cond, bar) do { unsigned _sp = 0; while (cond) { __builtin_amdgcn_s_sleep(1); \
    if ((++_sp & 255u) == 0u) { if (xb_ld(&(bar)[XB_TMO])) break; if (_sp > XB_SPIN_CAP) { atomicAdd(&(bar)[XB_TMO], 1u); break; } } } } while (0)
struct XcdBarrier { unsigned* bar; unsigned x; volatile LAS unsigned* st; };
__device__ __forceinline__ XcdBarrier xcd_barrier_post(unsigned* bar, volatile LAS unsigned* st) {
    XcdBarrier b; b.bar = bar; b.x = xb_xcc_id(); b.st = st;
    if (__builtin_amdgcn_workitem_id_x() == 0) (void)xb_add(&bar[XB_XCNT(b.x)], 1u);
    return b;
}
__device__ __forceinline__ void xcd_barrier_complete(unsigned* bar, unsigned x, unsigned& nloc, unsigned& nx) {
    const unsigned G = gridDim.x;
    unsigned sum, cnt, mine, sp = 0u;
    for (;;) {
        sum = 0u; cnt = 0u; mine = 0u;
#pragma unroll
        for (unsigned j = 0; j < 16; ++j) { const unsigned c = xb_ld(&bar[XB_XCNT(j)]); sum += c; cnt += (c > 0u) ? 1u : 0u; mine = (j == x) ? c : mine; }
        if (sum == G) break;
        __builtin_amdgcn_s_sleep(1);
        if ((++sp & 255u) == 0u) { if (xb_ld(&bar[XB_TMO])) break; if (sp > XB_SPIN_CAP) { atomicAdd(&bar[XB_TMO], 1u); break; } }
    }
    nloc = mine > 0u ? mine : 1u; nx = cnt > 0u ? cnt : 1u;
}
__device__ __forceinline__ void xcd_barrier(const XcdBarrier& b) {
    asm volatile("s_waitcnt vmcnt(0)" ::: "memory");
    __syncthreads();
    if (__builtin_amdgcn_workitem_id_x() == 0) {
        unsigned* bar = b.bar;
        __builtin_amdgcn_s_waitcnt(0);
        unsigned nloc = b.st[0], nx = b.st[1];
        if (nloc == 0u) { xcd_barrier_complete(bar, b.x, nloc, nx); b.st[0] = nloc; b.st[1] = nx; }
        const unsigned old = xb_add(&bar[XB_XSUB(b.x)], 1u);
        const unsigned gen = old / nloc;
        if (old + 1u == (gen + 1u) * nloc) {
            __builtin_amdgcn_fence(__ATOMIC_RELEASE, "agent");
            asm volatile("s_waitcnt vmcnt(0)" ::: "memory");
            const unsigned og = xb_add(&bar[XB_TOP], 1u);
            const unsigned tg = og / nx;
            if (og + 1u == (tg + 1u) * nx) xb_add(&bar[XB_TOPGEN], 1u);
            else XB_SPIN(xb_ld(&bar[XB_TOPGEN]) == tg, bar);
            __builtin_amdgcn_fence(__ATOMIC_ACQUIRE, "agent");
            xb_add(&bar[XB_XGEN(b.x)], 1u);
            asm volatile("s_waitcnt vmcnt(0)" ::: "memory");
        } else {
            XB_SPIN(xb_ld(&bar[XB_XGEN(b.x)]) == gen, bar);
            __builtin_amdgcn_fence(__ATOMIC_ACQUIRE, "agent");
            asm volatile("s_waitcnt vmcnt(0)" ::: "memory");
        }
    }
    __syncthreads();
}

__device__ __forceinline__ void gemm_call(const Params& p, int layer, int sub, int rep, unsigned char* smem) {
    LAS unsigned char* lds = (LAS unsigned char*)smem;
    bf16_t* H = (bf16_t*)(p.ws + WS_H); bf16_t* P = (bf16_t*)(p.ws + WS_P); float* X = (float*)(p.ws + WS_X);
    pg8::Gemm g; EpiAll E; pg8::StaticOrder S;
    E.O = P; E.ldc = NP; E.IKF = (bf16_t*)(p.ws + WS_IKF); E.sig_from = GA / 128; E.T = (float*)(p.ws + WS_T); E.Mout = (bf16_t*)(p.ws + WS_MM); E.Xin = (layer == 0) ? p.x : X; E.Xout = X; E.G = P + GA + rep * DM;
    g.M = MT;
    if (sub == 0) { g.A = H; g.Bt = (const bf16_t*)(p.ws + WS_WTIN + SZ_WTIN1 * layer); g.N = NP; g.K = DM; E.mode = 0; }
    else if (sub == 4) { g.A = (const bf16_t*)(p.ws + WS_YA + (size_t)rep * MT * 1024 * 2); g.Bt = (const bf16_t*)(p.ws + WS_WTPA + SZ_WTP1 * DEPTH * rep + SZ_WTP1 * layer); g.N = DM; g.K = 1024; E.mode = 1 + rep; }
    else { g.A = (const bf16_t*)(p.ws + WS_MM); g.Bt = (const bf16_t*)(p.ws + WS_WTO + SZ_WTO1 * layer); g.N = DM; g.K = DM; E.mode = 4; }
    S.init(MT, g.N, gridDim.x, blockIdx.x);
    pg8::gemm_phase(lds, g, S, E);
    __syncthreads();
}

#if MULTI_LAUNCH
__global__ void __launch_bounds__(512, 2) k_prep(Params p) { extern __shared__ __attribute__((aligned(16))) unsigned char smem[]; phase_prep(p, smem); }
__global__ void __launch_bounds__(512, 2) k_gemm(Params p, int layer, int sub, int rep) { extern __shared__ __attribute__((aligned(16))) unsigned char smem[]; gemm_call(p, layer, sub, rep, smem); }
__global__ void __launch_bounds__(512, 2) k_mix(Params p, int layer) { extern __shared__ __attribute__((aligned(16))) unsigned char smem[]; phase_mixprep(p, layer, smem); }
__global__ void __launch_bounds__(512, 2) k_attn(Params p) { extern __shared__ __attribute__((aligned(16))) unsigned char smem[]; phase_attn(p, smem); }
__global__ void __launch_bounds__(512, 2) k_norm(Params p, int layer) {
    float* X = (float*)(p.ws + WS_X);
    if (layer + 1 < DEPTH) rmsnorm_rows(X, p.norm_g + (size_t)(layer + 1) * DM, (bf16_t*)(p.ws + WS_H), nullptr);
    else rmsnorm_rows(X, p.final_g, nullptr, p.out);
}
#else
__global__ void __launch_bounds__(512, 2) fwd_megakernel(Params p) {
    extern __shared__ __attribute__((aligned(16))) unsigned char smem[];
    cg::grid_group grid = cg::this_grid();
    const int lo = p.ph_lo, hi = p.ph_hi;
    volatile LAS unsigned* xbst = (volatile LAS unsigned*)((LAS unsigned char*)smem + 131072);
    if (__builtin_amdgcn_workitem_id_x() == 0) { xbst[0] = 0u; xbst[1] = 0u; }
    __syncthreads();
    const XcdBarrier xbar = xcd_barrier_post((unsigned*)(p.ws + WS_BAR), xbst);
#define IN(k) (lo <= (k) && (k) < hi)
#define SEAM(k) do { if (IN(k) && IN((k) + 1)) { if ((k) == 0) grid.sync(); else xcd_barrier(xbar); } } while (0)
    for (int dup = 0; dup < 1 + ((PROBE_DUP >> 5) & 1); ++dup) { if (IN(0)) { phase_prep(p, smem); }
    SEAM(0); }
    for (int layer = 0; layer < DEPTH; ++layer) {
        const int b = 1 + 7 * layer;
        for (int dup = 0; dup < 1 + ((PROBE_DUP >> 0) & 1); ++dup) { if (IN(b + 0)) {
            gemm_call(p, layer, 0, 0, smem);
            const int nun = (MT / 256) * (NP / 256), rem = nun % (int)gridDim.x, idle = (int)gridDim.x - rem;
            if (layer + 1 < DEPTH && dup == 0) {
                if (rem == 0) convert_layer(p, (float*)smem, layer + 1, blockIdx.x, gridDim.x);
                else if ((int)blockIdx.x >= rem) convert_layer(p, (float*)smem, layer + 1, (int)blockIdx.x - rem, idle);
            } }
        SEAM(b + 0); }
        for (int dup = 0; dup < 1 + ((PROBE_DUP >> 1) & 1); ++dup) { if (IN(b + 1)) phase_mixprep(p, layer, smem);
        SEAM(b + 1); }
        for (int dup = 0; dup < 1 + ((PROBE_DUP >> 3) & 1); ++dup) { if (IN(b + 3)) phase_attn(p, smem);
        SEAM(b + 3); }
        for (int dup = 0; dup < 1 + ((PROBE_DUP >> 4) & 1); ++dup) { if (IN(b + 4)) { for (int rep = 0; rep < 3; ++rep) gemm_call(p, layer, 4, rep, smem); }
        SEAM(b + 4); }
        if (IN(b + 5)) gemm_call(p, layer, 5, 0, smem);
        SEAM(b + 5);
        if (IN(b + 6)) {
            float* X = (float*)(p.ws + WS_X);
            if (layer + 1 < DEPTH) rmsnorm_rows(X, p.norm_g + (size_t)(layer + 1) * DM, (bf16_t*)(p.ws + WS_H), nullptr);
            else rmsnorm_rows(X, p.final_g, nullptr, p.out);
        }
        SEAM(b + 6);
    }
#undef IN
#undef SEAM
}

#endif

extern "C" void kernel_launch(void* const* d_in, const int* in_sizes, int n_in, void* d_out, int out_size, void* d_ws, size_t ws_size, hipStream_t stream) {
    static int grid_blocks = 0;
    if (!grid_blocks) {
        if (n_in != 12 || out_size != MT * DM || ws_size < WS_END) { fprintf(stderr, "kernel_launch: unexpected shapes (n_in %d out %d ws %zu need %zu)\n", n_in, out_size, ws_size, (size_t)WS_END); grid_blocks = -1; return; }
        int dev = 0, cus = 0;
        (void)hipGetDevice(&dev);
        (void)hipDeviceGetAttribute(&cus, hipDeviceAttributeMultiprocessorCount, dev);
        bool ok = true;
#if MULTI_LAUNCH
        ok = ok && hipFuncSetAttribute((const void*)k_prep, hipFuncAttributeMaxDynamicSharedMemorySize, LDS_BYTES) == hipSuccess;
        ok = ok && hipFuncSetAttribute((const void*)k_gemm, hipFuncAttributeMaxDynamicSharedMemorySize, LDS_BYTES) == hipSuccess;
        ok = ok && hipFuncSetAttribute((const void*)k_mix, hipFuncAttributeMaxDynamicSharedMemorySize, LDS_BYTES) == hipSuccess;
        ok = ok && hipFuncSetAttribute((const void*)k_attn, hipFuncAttributeMaxDynamicSharedMemorySize, LDS_BYTES) == hipSuccess;
#else
        ok = ok && hipFuncSetAttribute((const void*)fwd_megakernel, hipFuncAttributeMaxDynamicSharedMemorySize, LDS_BYTES) == hipSuccess;
        int per_cu = 0;
        (void)hipOccupancyMaxActiveBlocksPerMultiprocessor(&per_cu, (const void*)fwd_megakernel, 512, LDS_BYTES);
        if (per_cu < 1) fprintf(stderr, "kernel_launch: occupancy query says %d blocks per CU\n", per_cu);
#endif
        if (!ok) { fprintf(stderr, "kernel_launch: hipFuncSetAttribute failed\n"); grid_blocks = -1; return; }
        grid_blocks = cus > 0 ? cus : 256;
    }
    if (grid_blocks < 0) return;
    Params p{};
    p.x = (const float*)d_in[0]; p.norm_g = (const float*)d_in[1]; p.w_in = (const float*)d_in[2]; p.a_ws = (const float*)d_in[3]; p.a_b = (const float*)d_in[4];
    p.b_conv = (const float*)d_in[5]; p.p_a = (const float*)d_in[6]; p.p_b = (const float*)d_in[7]; p.p_c = (const float*)d_in[8]; p.w_o = (const float*)d_in[9];
    p.rel_bias = (const float*)d_in[10]; p.final_g = (const float*)d_in[11];
    p.out = (float*)d_out; p.ws = (unsigned char*)d_ws;
#if MULTI_LAUNCH
    const dim3 G(grid_blocks), B(512);
    hipLaunchKernelGGL(k_prep, G, B, LDS_BYTES, stream, p);
    for (int layer = 0; layer < DEPTH; ++layer) {
        hipLaunchKernelGGL(k_gemm, G, B, LDS_BYTES, stream, p, layer, 0, 0);
        hipLaunchKernelGGL(k_mix, G, B, LDS_BYTES, stream, p, layer);
        hipLaunchKernelGGL(k_attn, G, B, LDS_BYTES, stream, p);
        for (int rep = 0; rep < 3; ++rep) hipLaunchKernelGGL(k_gemm, G, B, LDS_BYTES, stream, p, layer, 4, rep);
        hipLaunchKernelGGL(k_gemm, G, B, LDS_BYTES, stream, p, layer, 5, 0);
        hipLaunchKernelGGL(k_norm, G, B, 0, stream, p, layer);
    }
#else
    p.ph_lo = 0; p.ph_hi = NPHASES;
    (void)hipMemsetAsync((unsigned char*)d_ws + WS_BAR, 0, 16384, stream);
    void* args[] = {&p};
    hipError_t e = hipLaunchCooperativeKernel((const void*)fwd_megakernel, dim3(grid_blocks), dim3(512), args, LDS_BYTES, stream);
    if (e != hipSuccess) fprintf(stderr, "cooperative launch failed: %s (grid %d)\n", hipGetErrorString(e), grid_blocks);
#endif
}
```

```cpp
#include <hip/hip_runtime.h>
#include <hip/hip_cooperative_groups.h>
#include <cstdio>
#include <cmath>
namespace cg = cooperative_groups;

#ifndef MULTI_LAUNCH
#define MULTI_LAUNCH 0
#endif

#ifndef PROBE_MIX
#define PROBE_MIX 0
#endif
#ifndef PROBE_DUP
#define PROBE_DUP 0
#endif
#define LAS __attribute__((address_space(3)))
typedef unsigned short bf16_t;
typedef short bf16x8 __attribute__((ext_vector_type(8)));
typedef float f32x4 __attribute__((ext_vector_type(4)));
typedef float f32x16 __attribute__((ext_vector_type(16)));
typedef unsigned u32x4 __attribute__((ext_vector_type(4)));
typedef unsigned u32x2 __attribute__((ext_vector_type(2)));

constexpr int DM = 2048, NB = 4, SL = 4096, DEPTH = 4, MT = NB * SL;
constexpr int INC = 18512;
constexpr int NP = 18688;
constexpr int AU = 0, AV = 1024, AZ = 2048, BB = 3072, BC = 4096, BX = 5120, BZ = 6144, CQ = 7168, CK = 8192, CV = 9216, CZ = 10240,
              IQ = 11264, IK = 12288, IW = 12352, GA = 12416, GB = 14464, GC = 16512;
constexpr int NPHASES = 1 + 7 * DEPTH;

constexpr size_t WS_WTIN = 0;
constexpr size_t SZ_WTIN1 = (size_t)NP * DM * 2;
constexpr size_t WS_WTPA = WS_WTIN + SZ_WTIN1 * DEPTH;
constexpr size_t SZ_WTP1 = (size_t)DM * 1024 * 2;
constexpr size_t WS_WTPB = WS_WTPA + SZ_WTP1 * DEPTH;
constexpr size_t WS_WTPC = WS_WTPB + SZ_WTP1 * DEPTH;
constexpr size_t WS_WTO = WS_WTPC + SZ_WTP1 * DEPTH;
constexpr size_t SZ_WTO1 = (size_t)DM * DM * 2;
constexpr size_t WS_AWS = WS_WTO + SZ_WTO1 * DEPTH;
constexpr size_t SZ_AWS1 = (size_t)8 * 128 * 128 * 2;
constexpr size_t WS_H = WS_AWS + SZ_AWS1 * DEPTH;
constexpr size_t WS_P = WS_H + (size_t)MT * DM * 2;
constexpr size_t WS_X = WS_P + (size_t)MT * NP * 2;
constexpr size_t WS_YA = WS_X + (size_t)MT * DM * 4;
constexpr size_t WS_YB = WS_YA + (size_t)MT * 1024 * 2;
constexpr size_t WS_YC = WS_YB + (size_t)MT * 1024 * 2;
constexpr size_t WS_T = WS_YC + (size_t)MT * 1024 * 2;
constexpr size_t WS_MM = WS_T + (size_t)MT * DM * 4;
constexpr size_t WS_S = WS_MM + (size_t)MT * DM * 2;
constexpr size_t WS_MASK = WS_S + (size_t)MT * SL * 4;
constexpr size_t WS_VT = WS_MASK + (size_t)MT * 64 * 8;
constexpr size_t WS_BAR = WS_VT + (size_t)MT * 1024 * 2;
constexpr size_t WS_END = WS_BAR + 16384;

constexpr size_t WS_IKF = WS_S;
constexpr int LDS_BYTES = 131072 + 64;

struct Params {
    const float *x, *norm_g, *w_in, *a_ws, *a_b, *b_conv, *p_a, *p_b, *p_c, *w_o, *rel_bias, *final_g;
    float* out;
    unsigned char* ws;
    int ph_lo, ph_hi;
};

__device__ __forceinline__ size_t pidx(int tok, int col) { return ((size_t)((tok >> 8) * (NP / 256) + (col >> 8)) << 16) + (size_t)(((tok & 255) << 8) + (col & 255)); }
__device__ __forceinline__ unsigned cvt_pk_bf16(float lo, float hi) { unsigned r; asm("v_cvt_pk_bf16_f32 %0, %1, %2" : "=v"(r) : "v"(lo), "v"(hi)); return r; }
__device__ __forceinline__ int otid() { int t = __builtin_amdgcn_workitem_id_x(); asm volatile("" : "+v"(t)); return t; }
__device__ __forceinline__ float bf_lo(unsigned w) { return __uint_as_float(w << 16); }
__device__ __forceinline__ float bf_hi(unsigned w) { return __uint_as_float(w & 0xffff0000u); }
__device__ __forceinline__ float bf2f(bf16_t b) { return __uint_as_float(((unsigned)b) << 16); }
__device__ __forceinline__ float fast_exp2(float x) { return __builtin_amdgcn_exp2f(x); }
__device__ __forceinline__ float sigmoidf_(float x) { return __builtin_amdgcn_rcpf(1.0f + __expf(-x)); }
__device__ __forceinline__ float siluf_(float x) { return x * sigmoidf_(x); }

namespace pg8 {
constexpr int BM = 256, BK = 64, HALF = 128, HTB = HALF * BK * 2, STAGE_BYTES = 8 * HTB, NXCD = 8, WGM = 8;
__host__ __device__ __forceinline__ int lds_byte(int r, int c) { const int st = (r >> 4) * 2 + (c >> 5), rr = r & 15, cc = c & 31, ob = rr * 64 + cc * 2; return st * 1024 + (ob ^ (((ob >> 9) & 1) << 5)); }
__host__ __device__ __forceinline__ void stage_rc(int b, int& R, int& C) { const int st = b / 1024, sb = b % 1024, swz = sb ^ (((sb >> 9) & 1) << 5); R = (st >> 1) * 16 + swz / 64; C = (st & 1) * 32 + (swz % 64) / 2; }
__host__ __device__ __forceinline__ int perm32(int rho) { const int n = rho >> 4, i = rho & 15; return 8 * (i >> 2) + 4 * n + (i & 3); }
struct Unit { int pm, pn; };
struct Gemm { const bf16_t* A; const bf16_t* Bt; int M, N, K; };
struct StaticOrder {
    int nM, nN, nwg, G, c;
    __host__ __device__ void init(int M, int N, int G_, int c_) { nM = M / BM; nN = N / BM; nwg = nM * nN; G = G_; c = c_; }
    __host__ __device__ bool next(int i, Unit& u) const {
        const int L = i * G + c; if (L >= nwg) return false;
        const int wgid = (L & 7) * (nwg >> 3) + (L >> 3);
        int gid, within;
        if (nN == 8) { gid = wgid >> 6; within = wgid & 63; } else { gid = wgid / 584; within = wgid - gid * 584; }
        u.pm = gid * 8 + (within & 7); u.pn = within >> 3; return true;
    }
};

template <class Epi>
__device__ __forceinline__ void gemm_phase(LAS unsigned char* lds, const Gemm g, const StaticOrder& S, const Epi& E) {
    const int tid = otid(), wid = __builtin_amdgcn_readfirstlane(tid >> 6), lane = tid & 63, wr = wid >> 2, wc = wid & 3, fr = lane & 15, fq = lane >> 4;
    const int K = g.K, nt = K / BK;
    unsigned voffA[2], voffB[2];
#pragma unroll
    for (int i = 0; i < 2; ++i) { int R, C; stage_rc(tid * 16 + i * 8192, R, C); const int Rb = (R & ~31) + perm32(R & 31);
        voffA[i] = (unsigned)(R * K + C) * 2u; voffB[i] = (unsigned)(Rb * K + C) * 2u; }
    const size_t kstep = (size_t)(BK * 2);
    const size_t hstep = (size_t)HALF * K * 2;
    const size_t tstep = 2 * hstep;
    const unsigned ldsw = (unsigned)wid * 1024u;
    const int aoff = lds_byte(wr * 64 + fr, fq * 8), boff = lds_byte(wc * 32 + fr, fq * 8);
#define PG8_SA(b, h) (((b) * 2 + (h)) * HTB)
#define PG8_SB(b, h) ((4 + (b) * 2 + (h)) * HTB)
#define PG8_STAGE(bufoff, gbase, voff) do { _Pragma("unroll") for (int _i = 0; _i < 2; ++_i) \
        __builtin_amdgcn_global_load_lds((const unsigned*)((const char*)(gbase) + (voff)[_i]), (LAS unsigned*)(lds + (bufoff) + ldsw + _i * 8192), 16, 0, 0); } while (0)
#define PG8_LDA(dst, b, h) do { _Pragma("unroll") for (int m = 0; m < 4; ++m) _Pragma("unroll") for (int k = 0; k < 2; ++k) dst[m][k] = *(const LAS bf16x8*)(lds + PG8_SA(b, h) + aoff + m * 2048 + k * 1024); } while (0)
#define PG8_LDB(dst, b, h) do { _Pragma("unroll") for (int n = 0; n < 2; ++n) _Pragma("unroll") for (int k = 0; k < 2; ++k) dst[n][k] = *(const LAS bf16x8*)(lds + PG8_SB(b, h) + boff + n * 2048 + k * 1024); } while (0)
#define PG8_MMA(ai, bj, At, Bt) do { __builtin_amdgcn_s_setprio(1); _Pragma("unroll") for (int m = 0; m < 4; ++m) _Pragma("unroll") for (int n = 0; n < 2; ++n) _Pragma("unroll") for (int k = 0; k < 2; ++k) \
        acc[ai][bj][m][n] = __builtin_amdgcn_mfma_f32_16x16x32_bf16(Bt[n][k], At[m][k], acc[ai][bj][m][n], 0, 0, 0); __builtin_amdgcn_s_setprio(0); } while (0)
#define PG8_WAIT_V(n) asm volatile("s_waitcnt vmcnt(" #n ")" ::: "memory")
#define PG8_WAIT_L(n) asm volatile("s_waitcnt lgkmcnt(" #n ")" ::: "memory")
#define PG8_BAR __builtin_amdgcn_s_barrier()
#define PG8_SCHED __builtin_amdgcn_sched_barrier(0)
    Unit cur, nxt; int ui = 0;
    if (!S.next(0, cur)) return;
    f32x4 acc[2][2][4][2];
#pragma unroll
    for (int a = 0; a < 2; ++a)
#pragma unroll
        for (int b = 0; b < 2; ++b)
#pragma unroll
            for (int m = 0; m < 4; ++m)
#pragma unroll
                for (int n = 0; n < 2; ++n) acc[a][b][m][n] = (f32x4){0.f, 0.f, 0.f, 0.f};
    bf16x8 At[4][2], B0[2][2], B1[2][2];
    const char* cA = (const char*)g.A + (size_t)cur.pm * tstep; const char* cB = (const char*)g.Bt + (size_t)cur.pn * tstep;
    PG8_STAGE(PG8_SB(0, 0), cB, voffB); PG8_STAGE(PG8_SB(0, 1), cB + hstep, voffB); PG8_STAGE(PG8_SA(0, 0), cA, voffA); PG8_STAGE(PG8_SA(0, 1), cA + hstep, voffA);
    if (wr == 1) PG8_BAR;
    PG8_WAIT_V(2); PG8_BAR;
    PG8_STAGE(PG8_SB(1, 0), cB + kstep, voffB); PG8_STAGE(PG8_SA(1, 0), cA + kstep, voffA); PG8_STAGE(PG8_SB(1, 1), cB + hstep + kstep, voffB);
    PG8_WAIT_V(6); PG8_BAR;
    for (;;) {
        const bool has_next = S.next(ui + 1, nxt);
        const char* nA = has_next ? (const char*)g.A + (size_t)nxt.pm * tstep : cA; const char* nB = has_next ? (const char*)g.Bt + (size_t)nxt.pn * tstep : cB;
        for (int t = 0; t < nt; t += 2) {
            const bool last = (t == nt - 2);
            const char* a1 = cA + (size_t)(t + 1) * kstep;
            const char* a2 = last ? nA : cA + (size_t)(t + 2) * kstep; const char* b2 = last ? nB : cB + (size_t)(t + 2) * kstep;
            const char* a3 = a2 + kstep; const char* b3 = b2 + kstep;
            PG8_LDB(B0, 0, 0); PG8_LDB(B1, 0, 1); PG8_SCHED; PG8_LDA(At, 0, 0); PG8_STAGE(PG8_SA(1, 1), a1 + hstep, voffA);
            PG8_WAIT_V(8); PG8_WAIT_L(0); PG8_BAR; PG8_MMA(0, 0, At, B0); PG8_MMA(0, 1, At, B1); PG8_BAR; PG8_SCHED;
            PG8_LDA(At, 0, 1); PG8_STAGE(PG8_SB(0, 0), b2, voffB); PG8_STAGE(PG8_SB(0, 1), b2 + hstep, voffB); PG8_STAGE(PG8_SA(0, 0), a2, voffA);
            PG8_WAIT_V(8); PG8_WAIT_L(0); PG8_BAR; PG8_MMA(1, 0, At, B0); PG8_MMA(1, 1, At, B1); PG8_BAR; PG8_SCHED;
            PG8_LDB(B0, 1, 0); PG8_LDB(B1, 1, 1); PG8_SCHED; PG8_LDA(At, 1, 0); PG8_STAGE(PG8_SA(0, 1), a2 + hstep, voffA);
            PG8_WAIT_V(8); PG8_WAIT_L(0); PG8_BAR; PG8_MMA(0, 0, At, B0); PG8_MMA(0, 1, At, B1); PG8_BAR; PG8_SCHED;
            PG8_LDA(At, 1, 1); PG8_STAGE(PG8_SB(1, 0), b3, voffB); PG8_STAGE(PG8_SB(1, 1), b3 + hstep, voffB); PG8_STAGE(PG8_SA(1, 0), a3, voffA);
            PG8_WAIT_V(8); PG8_WAIT_L(0); PG8_BAR; PG8_MMA(1, 0, At, B0); PG8_MMA(1, 1, At, B1); PG8_BAR; PG8_SCHED;
        }
        if (wr == 0) PG8_BAR;
        E(acc, cur, wr, wc, fr, fq);
        if (!has_next) break;
#pragma unroll
        for (int a = 0; a < 2; ++a)
#pragma unroll
            for (int b = 0; b < 2; ++b)
#pragma unroll
                for (int m = 0; m < 4; ++m)
#pragma unroll
                    for (int n = 0; n < 2; ++n) acc[a][b][m][n] = (f32x4){0.f, 0.f, 0.f, 0.f};
        cur = nxt; cA = nA; cB = nB; ++ui;
        if (wr == 1) PG8_BAR;
    }
    PG8_WAIT_V(0);
    PG8_BAR;
#undef PG8_SA
#undef PG8_SB
#undef PG8_STAGE
#undef PG8_LDA
#undef PG8_LDB
#undef PG8_MMA
#undef PG8_WAIT_V
#undef PG8_WAIT_L
#undef PG8_BAR
#undef PG8_SCHED
}
}

struct EpiAll {
    int mode; bf16_t* O; int ldc; int sig_from; int gcol0; float* T; bf16_t* Mout; const float* Xin; float* Xout; bf16_t* IKF;
    __device__ __forceinline__ void operator()(const f32x4 (&acc)[2][2][4][2], const pg8::Unit& u, int wr, int wc, int fr, int fq) const {
        const int row0 = u.pm * 256 + wr * 64 + fr, col0 = u.pn * 256 + wc * 32 + 8 * fq;
        if (mode == 0) {
            for (int dup_ = 0; dup_ < 1 + ((PROBE_DUP >> 7) & 1); ++dup_)
#pragma unroll
            for (int bj = 0; bj < 2; ++bj) {
                const bool sg = (u.pn * 2 + bj) >= sig_from;
                const int col = col0 + bj * 128;
#pragma unroll
                for (int ai = 0; ai < 2; ++ai)
#pragma unroll
                    for (int m = 0; m < 4; ++m) { const size_t row = (size_t)(row0 + ai * 128 + m * 16);
                        f32x4 v0 = acc[ai][bj][m][0], v1 = acc[ai][bj][m][1];
                        if (sg) {
#pragma unroll
                            for (int j = 0; j < 4; ++j) { v0[j] = sigmoidf_(v0[j]); v1[j] = sigmoidf_(v1[j]); } }
                        u32x4 w; w.x = cvt_pk_bf16(v0[0], v0[1]); w.y = cvt_pk_bf16(v0[2], v0[3]); w.z = cvt_pk_bf16(v1[0], v1[1]); w.w = cvt_pk_bf16(v1[2], v1[3]);
                        *(u32x4*)(O + pidx((int)row, col)) = w;
                        if (col >= IK && col < IK + 64) {
                            const int kg = (col - IK) >> 3;
                            *(u32x4*)(IKF + ((row >> 5) * 4 + (kg >> 1)) * 512 + (((int)row & 31) + 32 * (kg & 1)) * 8) = w; }
                    }
            }
        } else if (mode <= 3) {
            u32x4 gw[2], tw[2], gn[2], tn[2], gm[2], tm[2];
#define EPI_LD(s_, G_, T_) do { const int bj_ = (s_) >> 2, ai_ = ((s_) >> 1) & 1, mb_ = ((s_) & 1) * 2; \
                _Pragma("unroll") for (int mm = 0; mm < 2; ++mm) { const size_t row = (size_t)(row0 + ai_ * 128 + (mb_ + mm) * 16); const int col = col0 + bj_ * 128; \
                    G_[mm] = *(const u32x4*)(O + pidx((int)row, gcol0 + col)); if (mode >= 2) T_[mm] = *(const u32x4*)(Mout + row * DM + col); } } while (0)
            EPI_LD(0, gw, tw); EPI_LD(1, gn, tn);
#pragma unroll
            for (int s = 0; s < 8; ++s) { const int bj = s >> 2, ai = (s >> 1) & 1, mb = (s & 1) * 2, col = col0 + bj * 128;
                if (s < 6) EPI_LD(s + 2, gm, tm);
                asm volatile("" ::: "memory");
#pragma unroll
                for (int mm = 0; mm < 2; ++mm) { const int m = mb + mm; const size_t row = (size_t)(row0 + ai * 128 + m * 16);
                    f32x4 v0 = acc[ai][bj][m][0], v1 = acc[ai][bj][m][1];
                    v0[0] *= bf_lo(gw[mm].x); v0[1] *= bf_hi(gw[mm].x); v0[2] *= bf_lo(gw[mm].y); v0[3] *= bf_hi(gw[mm].y);
                    v1[0] *= bf_lo(gw[mm].z); v1[1] *= bf_hi(gw[mm].z); v1[2] *= bf_lo(gw[mm].w); v1[3] *= bf_hi(gw[mm].w);
                    if (mode >= 2) { v0[0] += bf_lo(tw[mm].x); v0[1] += bf_hi(tw[mm].x); v0[2] += bf_lo(tw[mm].y); v0[3] += bf_hi(tw[mm].y);
                        v1[0] += bf_lo(tw[mm].z); v1[1] += bf_hi(tw[mm].z); v1[2] += bf_lo(tw[mm].w); v1[3] += bf_hi(tw[mm].w); }
                    u32x4 w; w.x = cvt_pk_bf16(v0[0], v0[1]); w.y = cvt_pk_bf16(v0[2], v0[3]); w.z = cvt_pk_bf16(v1[0], v1[1]); w.w = cvt_pk_bf16(v1[2], v1[3]);
                    *(u32x4*)(Mout + row * DM + col) = w; }
                asm volatile("" ::: "memory");
#pragma unroll
                for (int mm = 0; mm < 2; ++mm) { gw[mm] = gn[mm]; tw[mm] = tn[mm]; gn[mm] = gm[mm]; tn[mm] = tm[mm]; }
            }
#undef EPI_LD
        } else {
            f32x4 xa[2], xb[2], xan[2], xbn[2];
#define EPI_LD(s_, A_, B_) do { const int bj_ = (s_) >> 2, ai_ = ((s_) >> 1) & 1, mb_ = ((s_) & 1) * 2; \
                _Pragma("unroll") for (int mm = 0; mm < 2; ++mm) { const size_t o = (size_t)(row0 + ai_ * 128 + (mb_ + mm) * 16) * DM + col0 + bj_ * 128; \
                    A_[mm] = *(const f32x4*)(Xin + o); B_[mm] = *(const f32x4*)(Xin + o + 4); } } while (0)
            EPI_LD(0, xa, xb);
#pragma unroll
            for (int s = 0; s < 8; ++s) { const int bj = s >> 2, ai = (s >> 1) & 1, mb = (s & 1) * 2;
                if (s < 7) EPI_LD(s + 1, xan, xbn);
                asm volatile("" ::: "memory");
#pragma unroll
                for (int mm = 0; mm < 2; ++mm) { const size_t o = (size_t)(row0 + ai * 128 + (mb + mm) * 16) * DM + col0 + bj * 128;
                    *(f32x4*)(Xout + o) = xa[mm] + acc[ai][bj][mb + mm][0]; *(f32x4*)(Xout + o + 4) = xb[mm] + acc[ai][bj][mb + mm][1]; }
                asm volatile("" ::: "memory");
#pragma unroll
                for (int mm = 0; mm < 2; ++mm) { xa[mm] = xan[mm]; xb[mm] = xbn[mm]; }
            }
#undef EPI_LD
        }
    }
};

__device__ __forceinline__ void tcvt_load(const float* __restrict__ src, int ld_src, int k0, int n0, int mode, f32x4 (&v)[2]) {
    const int tid = otid();
#pragma unroll
    for (int i = 0; i < 2; ++i) {
        const int idx = tid + 512 * i, kk = idx >> 4, nq = idx & 15, n = n0 + 4 * nq;
        int sc = n; bool valid = true;
        if (mode == 1) { if (n < 12368) sc = n; else if (n < 12416) valid = false; else if (n < 18560) sc = n - 48; else valid = false; }
        v[i] = (f32x4){0.f, 0.f, 0.f, 0.f};
        if (valid) v[i] = *(const f32x4*)(src + (size_t)(k0 + kk) * ld_src + sc);
    }
}
__device__ __forceinline__ void tcvt_lds_write(const f32x4 (&v)[2], float* tile) {
    const int tid = otid();
#pragma unroll
    for (int i = 0; i < 2; ++i) { const int idx = tid + 512 * i, kk = idx >> 4, nq = idx & 15;
        float* tp = tile + kk * 65 + 4 * nq; tp[0] = v[i][0]; tp[1] = v[i][1]; tp[2] = v[i][2]; tp[3] = v[i][3]; }
}
__device__ __forceinline__ void tcvt_store(bf16_t* __restrict__ dst, int K, int k0, int n0, const float* tile) {
    const int tid = otid();
    const int n = tid >> 3, kc = tid & 7; const float* tp = tile + (kc * 8) * 65 + n;
    u32x4 w; w.x = cvt_pk_bf16(tp[0], tp[65]); w.y = cvt_pk_bf16(tp[130], tp[195]); w.z = cvt_pk_bf16(tp[260], tp[325]); w.w = cvt_pk_bf16(tp[390], tp[455]);
    *(u32x4*)(dst + (size_t)(n0 + n) * K + k0 + kc * 8) = w;
}

__device__ __forceinline__ void rmsnorm_rows(const float* __restrict__ X, const float* __restrict__ g, bf16_t* __restrict__ H, float* __restrict__ Out) {
    const int lane = otid() & 63, gw = blockIdx.x * 8 + (otid() >> 6), nw = gridDim.x * 8;
    for (int row = gw; row < MT; row += nw) {
        const f32x4* xr = (const f32x4*)(X + (size_t)row * DM);
        f32x4 v[8]; float ss = 0.f;
#pragma unroll
        for (int i = 0; i < 8; ++i) { v[i] = xr[lane + 64 * i]; ss += v[i][0] * v[i][0] + v[i][1] * v[i][1] + v[i][2] * v[i][2] + v[i][3] * v[i][3]; }
#pragma unroll
        for (int o = 32; o >= 1; o >>= 1) ss += __shfl_xor(ss, o);
        const float rstd = rsqrtf(ss * (1.0f / DM) + 1e-6f);
#pragma unroll
        for (int i = 0; i < 8; ++i) { const f32x4 gg = *(const f32x4*)(g + 4 * (lane + 64 * i));
            const float a = v[i][0] * rstd * gg[0], b = v[i][1] * rstd * gg[1], c = v[i][2] * rstd * gg[2], d = v[i][3] * rstd * gg[3];
            if (H) { u32x2 w; w.x = cvt_pk_bf16(a, b); w.y = cvt_pk_bf16(c, d); *(u32x2*)(H + (size_t)row * DM + 4 * (lane + 64 * i)) = w; }
            else { *(f32x4*)(Out + (size_t)row * DM + 4 * (lane + 64 * i)) = (f32x4){a, b, c, d}; } }
    }
}

__device__ __forceinline__ void convert_layer(const Params& p, float* tile, int l, int bid, int nb) {
    int base = 0;
    for (int kind = 0; kind < 5; ++kind) {
        const float* src; bf16_t* dst; int ld_src, K, ntn, mode = 0;
        if (kind == 0) { src = p.w_in + (size_t)l * DM * INC; dst = (bf16_t*)(p.ws + WS_WTIN + SZ_WTIN1 * l); ld_src = INC; K = DM; ntn = NP / 64; mode = 1; }
        else if (kind == 4) { src = p.w_o + (size_t)l * DM * DM; dst = (bf16_t*)(p.ws + WS_WTO + SZ_WTO1 * l); ld_src = DM; K = DM; ntn = DM / 64; }
        else { const float* s3 = kind == 1 ? p.p_a : (kind == 2 ? p.p_b : p.p_c); const size_t o3 = kind == 1 ? WS_WTPA : (kind == 2 ? WS_WTPB : WS_WTPC);
            src = s3 + (size_t)l * 1024 * DM; dst = (bf16_t*)(p.ws + o3 + SZ_WTP1 * l); ld_src = DM; K = 1024; ntn = DM / 64; }
        const int cnt = ntn * (K / 64);
        int first = (bid - base) % nb; if (first < 0) first += nb;
        f32x4 v[2];
        if (first < cnt) tcvt_load(src, ld_src, (first / ntn) * 64, (first % ntn) * 64, mode, v);
        for (int j = first; j < cnt; j += nb) {
            const int kt = j / ntn, nt = j % ntn;
            tcvt_lds_write(v, tile);
            __syncthreads();
            if (j + nb < cnt) tcvt_load(src, ld_src, ((j + nb) / ntn) * 64, ((j + nb) % ntn) * 64, mode, v);
            tcvt_store(dst, K, kt * 64, nt * 64, tile);
            __syncthreads();
        }
        base += cnt;
    }
}

__device__ __forceinline__ void phase_prep(const Params& p, unsigned char* smem) {
    float* tile = (float*)smem;
    const int bid = blockIdx.x, nb = gridDim.x;
    convert_layer(p, tile, 0, bid, nb);
    { bf16_t* aw = (bf16_t*)(p.ws + WS_AWS); const int n = DEPTH * 8 * 128 * 128;
      for (int i = bid * 512 + otid(); i < n; i += nb * 512) { const int s = i & 127, t = (i >> 7) & 127; const float v = (s <= t) ? p.a_ws[i] : 0.f; aw[i] = (bf16_t)(cvt_pk_bf16(v, 0.f) & 0xffffu); } }
    rmsnorm_rows(p.x, p.norm_g, (bf16_t*)(p.ws + WS_H), nullptr);
}

__device__ __forceinline__ void isel_item(const Params& p, int item, unsigned char* smem) {
    const bf16_t* P = (const bf16_t*)(p.ws + WS_P); unsigned long long* MK = (unsigned long long*)(p.ws + WS_MASK);
    unsigned* SU = (unsigned*)smem;
    const int tid = otid(), lane = tid & 63, w = __builtin_amdgcn_readfirstlane(tid >> 6), hh = lane >> 5, l31 = lane & 31;
    const int b = item >> 9, t0 = (((item >> 8) & 1) ? 511 - (item & 255) : (item & 255)) * 8;
    const int nkt = ((t0 + 7) >> 5) + 1;
    {
        bf16x8 Af[4][4]; float wv[4][16];
        const int qq = (l31 >> 2) & 1, hd = (l31 & 3) + 4 * (l31 >> 3);
#pragma unroll
        for (int rt = 0; rt < 4; ++rt) { const bf16_t* bp = P + pidx(b * SL + t0 + 2 * rt + qq, IQ + hd * 64 + hh * 8);
#pragma unroll
            for (int ks = 0; ks < 4; ++ks) Af[rt][ks] = *(const bf16x8*)(bp + ks * 16);
            const u32x4* wp = (const u32x4*)(P + pidx(b * SL + t0 + 2 * rt + hh, IW));
            const u32x4 w0 = wp[0], w1 = wp[1];
            const float sc = 1.0f / 32.0f;
            wv[rt][0] = bf_lo(w0.x) * sc; wv[rt][1] = bf_hi(w0.x) * sc; wv[rt][2] = bf_lo(w0.y) * sc; wv[rt][3] = bf_hi(w0.y) * sc;
            wv[rt][4] = bf_lo(w0.z) * sc; wv[rt][5] = bf_hi(w0.z) * sc; wv[rt][6] = bf_lo(w0.w) * sc; wv[rt][7] = bf_hi(w0.w) * sc;
            wv[rt][8] = bf_lo(w1.x) * sc; wv[rt][9] = bf_hi(w1.x) * sc; wv[rt][10] = bf_lo(w1.y) * sc; wv[rt][11] = bf_hi(w1.y) * sc;
            wv[rt][12] = bf_lo(w1.z) * sc; wv[rt][13] = bf_hi(w1.z) * sc; wv[rt][14] = bf_lo(w1.w) * sc; wv[rt][15] = bf_hi(w1.w) * sc; }
        const bf16_t* kb = (const bf16_t*)(p.ws + WS_IKF) + (size_t)(b * (SL / 32)) * 2048 + lane * 8;
        bf16x8 Bf[4];
        if (w < nkt) {
#pragma unroll
            for (int ks = 0; ks < 4; ++ks) Bf[ks] = *(const bf16x8*)(kb + (size_t)w * 2048 + ks * 512);
        }
        for (int j = w; j < nkt; j += 8) {
            f32x16 acc[4];
#pragma unroll
            for (int rt = 0; rt < 4; ++rt) acc[rt] = (f32x16){};
#pragma unroll
            for (int ks = 0; ks < 4; ++ks)
#pragma unroll
                for (int rt = 0; rt < 4; ++rt) acc[rt] = __builtin_amdgcn_mfma_f32_32x32x16_bf16(Af[rt][ks], Bf[ks], acc[rt], 0, 0, 0);
            if (j + 8 < nkt) {
#pragma unroll
                for (int ks = 0; ks < 4; ++ks) Bf[ks] = *(const bf16x8*)(kb + (size_t)(j + 8) * 2048 + ks * 512);
            }
            const int key = 32 * j + l31;
#pragma unroll
            for (int rt = 0; rt < 4; ++rt) {
                float sv = 0.f;
#pragma unroll
                for (int q = 0; q < 16; ++q) sv += wv[rt][q] * fmaxf(acc[rt][q], 0.f);
                const int qi = 2 * rt + hh;
                const unsigned bits = __float_as_uint(sv);
                const unsigned uu = bits ^ ((bits >> 31) ? 0xffffffffu : 0x80000000u);
                SU[qi * 4096 + key] = (key <= t0 + qi) ? uu : 0u;
            }
        }
    }
    __syncthreads();
    {
        const int t = t0 + w, njw = (t >> 6) + 1, q = b * SL + t;
        const unsigned* row = SU + w * 4096;
        unsigned u[64];
#pragma unroll
        for (int jb = 0; jb < 8; ++jb) {
            if (jb * 8 < njw) {
#pragma unroll
                for (int jj = 0; jj < 8; ++jj) { const int j = jb * 8 + jj, key = 64 * j + lane; u[j] = (key <= t) ? row[key] : 0u; }
            } else {
#pragma unroll
                for (int jj = 0; jj < 8; ++jj) u[jb * 8 + jj] = 0;
            }
        }
        unsigned T = 1u; bool exact = true; int need = 0;
        if (t >= 256) {
            unsigned* hist = SU + w * 4096;
#pragma unroll
            for (int i = 0; i < 16; ++i) *(u32x4*)(hist + 4 * (lane + 64 * i)) = (u32x4){0u, 0u, 0u, 0u};
            asm volatile("" ::: "memory");
#pragma unroll
            for (int jb = 0; jb < 8; ++jb) if (jb * 8 < njw) {
#pragma unroll
                for (int jj = 0; jj < 8; ++jj) { const unsigned v = u[jb * 8 + jj];
                    __hip_atomic_fetch_add(hist + (v ? (v >> 20) : (unsigned)lane), 1u, __ATOMIC_RELAXED, __HIP_MEMORY_SCOPE_WORKGROUP); } }
            asm volatile("" ::: "memory");
            int sl = 0;
#pragma unroll
            for (int i = 0; i < 16; ++i) { const u32x4 h4 = *(const u32x4*)(hist + 64 * lane + 4 * i); sl += (int)(h4.x + h4.y + h4.z + h4.w); }
            int suf = sl;
#pragma unroll
            for (int o = 1; o < 64; o <<= 1) { const int v = __shfl_down(suf, o); if (lane + o < 64) suf += v; }
            const unsigned long long okm = __ballot(suf >= 256);
            const int Lh = 63 - __clzll(okm);
            const int sufL = __shfl(suf, Lh), slL = __shfl(sl, Lh);
            const int above = sufL - slL;
            int hs = (int)hist[64 * Lh + lane];
#pragma unroll
            for (int o = 1; o < 64; o <<= 1) { const int v = __shfl_down(hs, o); if (lane + o < 64) hs += v; }
            const unsigned long long okb = __ballot(hs + above >= 256);
            const int Ib = 63 - __clzll(okb);
            T = (unsigned)(64 * Lh + Ib) << 20; exact = false;
            for (int bit = 19; bit >= 0; --bit) {
                const unsigned cand = T | (1u << bit); int cl = 0;
#pragma unroll
                for (int jb = 0; jb < 8; ++jb) if (jb * 8 < njw) {
#pragma unroll
                    for (int jj = 0; jj < 8; ++jj) cl += (u[jb * 8 + jj] >= cand) ? 1 : 0; }
                int cnt = 0;
#pragma unroll
                for (int bb = 0; bb < 7; ++bb) cnt += __popcll(__ballot((cl >> bb) & 1)) << bb;
                if (cnt >= 256) { T = cand; if (cnt == 256) { exact = true; break; } }
            }
            if (!exact) { int cgt = 0;
#pragma unroll
                for (int j = 0; j < 64; ++j) cgt += __popcll(__ballot(u[j] > T));
                need = 256 - cgt; }
        }
        unsigned long long myw = 0;
        if (exact) {
#pragma unroll
            for (int j = 0; j < 64; ++j) { const unsigned long long m = __ballot(u[j] >= T); if (lane == j) myw = m; }
        } else {
#pragma unroll
            for (int j = 0; j < 64; ++j) {
                const unsigned long long gt = __ballot(u[j] > T); unsigned long long eq = __ballot(u[j] == T);
                while (__popcll(eq) > need) eq &= ~(1ull << (63 - __clzll(eq)));
                need -= __popcll(eq);
                const unsigned long long m = gt | eq; if (lane == j) myw = m; }
        }
        MK[(size_t)q * 64 + lane] = myw;
    }
    __syncthreads();
}

__device__ __forceinline__ void sgu_item(const Params& p, int layer, int item, unsigned char* smem) {
    const bf16_t* P = (const bf16_t*)(p.ws + WS_P); bf16_t* YA = (bf16_t*)(p.ws + WS_YA);
    const bf16_t* aws = (const bf16_t*)(p.ws + WS_AWS + SZ_AWS1 * layer);
    const int tid = otid(), lane = tid & 63, w = tid >> 6, hh = lane >> 5, l31 = lane & 31;
    const int b = item >> 8, n = (item >> 3) & 31, g = item & 7, tok0 = b * SL + n * 128;
#pragma unroll
    for (int i = 0; i < 4; ++i) { const int ch = tid + 512 * i, c8 = ch >> 7, s = ch & 127;
        const u32x4 v = *(const u32x4*)(P + pidx(tok0 + s, AV + g * 128 + c8 * 8));
        unsigned char* d = smem + (c8 * 8) * 272 + s * 2;
        *(bf16_t*)(d + 0 * 272) = (bf16_t)(v.x & 0xffff); *(bf16_t*)(d + 1 * 272) = (bf16_t)(v.x >> 16);
        *(bf16_t*)(d + 2 * 272) = (bf16_t)(v.y & 0xffff); *(bf16_t*)(d + 3 * 272) = (bf16_t)(v.y >> 16);
        *(bf16_t*)(d + 4 * 272) = (bf16_t)(v.z & 0xffff); *(bf16_t*)(d + 5 * 272) = (bf16_t)(v.z >> 16);
        *(bf16_t*)(d + 6 * 272) = (bf16_t)(v.w & 0xffff); *(bf16_t*)(d + 7 * 272) = (bf16_t)(v.w >> 16); }
    __syncthreads();
    const int tt = w & 3, cp = w >> 2, t = 32 * tt + l31, tok = tok0 + t;
    const float bias = p.a_b[(size_t)(layer * 8 + g) * 128 + t];
    const bf16_t* wsrow = aws + ((size_t)g * 128 + t) * 128 + hh * 8;
#pragma unroll
    for (int ci = 0; ci < 2; ++ci) {
        const int ct = cp * 2 + ci;
        f32x16 acc = {};
        for (int ks = 0; ks < 2 * (tt + 1); ++ks) {
            const bf16x8 A = *(const bf16x8*)(smem + (32 * ct + l31) * 272 + (ks * 16 + hh * 8) * 2);
            const bf16x8 Bv = *(const bf16x8*)(wsrow + ks * 16);
            acc = __builtin_amdgcn_mfma_f32_32x32x16_bf16(A, Bv, acc, 0, 0, 0);
        }
#pragma unroll
        for (int q4 = 0; q4 < 4; ++q4) {
            const int c = g * 128 + 32 * ct + 8 * q4 + 4 * hh;
            const u32x2 u4 = *(const u32x2*)(P + pidx(tok, AU + c)), z4 = *(const u32x2*)(P + pidx(tok, AZ + c));
            const float y0 = bf_lo(u4.x) * (acc[4 * q4 + 0] + bias) * siluf_(bf_lo(z4.x));
            const float y1 = bf_hi(u4.x) * (acc[4 * q4 + 1] + bias) * siluf_(bf_hi(z4.x));
            const float y2 = bf_lo(u4.y) * (acc[4 * q4 + 2] + bias) * siluf_(bf_lo(z4.y));
            const float y3 = bf_hi(u4.y) * (acc[4 * q4 + 3] + bias) * siluf_(bf_hi(z4.y));
            u32x2 o; o.x = cvt_pk_bf16(y0, y1); o.y = cvt_pk_bf16(y2, y3);
            *(u32x2*)(YA + (size_t)tok * 1024 + c) = o;
        }
    }
    __syncthreads();
}

__device__ __forceinline__ void vt_item(const Params& p, int item, unsigned char* smem) {
    const bf16_t* P = (const bf16_t*)(p.ws + WS_P); bf16_t* VT = (bf16_t*)(p.ws + WS_VT);
    const int tid = otid();
    const int b = item >> 9, h = (item >> 6) & 7, st = item & 63;
#pragma unroll
    for (int i = 0; i < 2; ++i) { const int ch = tid + 512 * i, d8 = ch >> 6, s = ch & 63;
        const u32x4 v = *(const u32x4*)(P + pidx(b * SL + st * 64 + s, CV + h * 128 + d8 * 8));
        unsigned char* d = smem + (d8 * 8) * 144 + s * 2;
        *(bf16_t*)(d + 0 * 144) = (bf16_t)(v.x & 0xffff); *(bf16_t*)(d + 1 * 144) = (bf16_t)(v.x >> 16);
        *(bf16_t*)(d + 2 * 144) = (bf16_t)(v.y & 0xffff); *(bf16_t*)(d + 3 * 144) = (bf16_t)(v.y >> 16);
        *(bf16_t*)(d + 4 * 144) = (bf16_t)(v.z & 0xffff); *(bf16_t*)(d + 5 * 144) = (bf16_t)(v.z >> 16);
        *(bf16_t*)(d + 6 * 144) = (bf16_t)(v.w & 0xffff); *(bf16_t*)(d + 7 * 144) = (bf16_t)(v.w >> 16); }
    __syncthreads();
#pragma unroll
    for (int i = 0; i < 2; ++i) { const int ch = tid + 512 * i, d = ch >> 3, c16 = ch & 7;
        const u32x4 v = *(const u32x4*)(smem + d * 144 + c16 * 16);
        *(u32x4*)(VT + ((size_t)((b * 8 + h) * 128 + d)) * SL + st * 64 + c16 * 8) = v; }
    __syncthreads();
}

__device__ __forceinline__ void conv_item(const Params& p, int layer, int item) {
    const bf16_t* P = (const bf16_t*)(p.ws + WS_P); bf16_t* YB = (bf16_t*)(p.ws + WS_YB);
    const float* cw = p.b_conv + (size_t)layer * 3 * 1024;
    const int tid = otid();
#pragma unroll
    for (int i = 0; i < 4; ++i) {
        const int idx = tid + 512 * i, tk = idx >> 7, c = (idx & 127) * 8, tok = item * 16 + tk, tpos = tok & (SL - 1);
        const u32x4 bg = *(const u32x4*)(P + pidx(tok, BB + c)), zz = *(const u32x4*)(P + pidx(tok, BZ + c));
        const u32x4 c0 = *(const u32x4*)(P + pidx(tok, BC + c)), x0 = *(const u32x4*)(P + pidx(tok, BX + c));
        u32x4 c1 = (u32x4){0, 0, 0, 0}, x1 = c1, c2 = c1, x2 = c1;
        if (tpos >= 1) { c1 = *(const u32x4*)(P + pidx(tok - 1, BC + c)); x1 = *(const u32x4*)(P + pidx(tok - 1, BX + c)); }
        if (tpos >= 2) { c2 = *(const u32x4*)(P + pidx(tok - 2, BC + c)); x2 = *(const u32x4*)(P + pidx(tok - 2, BX + c)); }
        float y[8];
#pragma unroll
        for (int e = 0; e < 8; ++e) {
            const int wi = e >> 1; const bool hi = e & 1;
            const unsigned bgw = bg[wi], zw = zz[wi], c0w = c0[wi], x0w = x0[wi], c1w = c1[wi], x1w = x1[wi], c2w = c2[wi], x2w = x2[wi];
            const float fb = hi ? bf_hi(bgw) : bf_lo(bgw), fz = hi ? bf_hi(zw) : bf_lo(zw);
            const float a0 = (hi ? bf_hi(c0w) : bf_lo(c0w)) * (hi ? bf_hi(x0w) : bf_lo(x0w));
            const float a1 = (hi ? bf_hi(c1w) : bf_lo(c1w)) * (hi ? bf_hi(x1w) : bf_lo(x1w));
            const float a2 = (hi ? bf_hi(c2w) : bf_lo(c2w)) * (hi ? bf_hi(x2w) : bf_lo(x2w));
            const float cv = cw[2048 + c + e] * a0 + cw[1024 + c + e] * a1 + cw[c + e] * a2;
            y[e] = fb * cv * siluf_(fz);
        }
        u32x4 o; o.x = cvt_pk_bf16(y[0], y[1]); o.y = cvt_pk_bf16(y[2], y[3]); o.z = cvt_pk_bf16(y[4], y[5]); o.w = cvt_pk_bf16(y[6], y[7]);
        *(u32x4*)(YB + (size_t)tok * 1024 + c) = o;
    }
}

__device__ __forceinline__ void phase_mixprep(const Params& p, int layer, unsigned char* smem) {
    constexpr int nI = 2048, nA = 1024, nV = 2048, nC = 1024;
    for (int j = blockIdx.x; j < nI + nA + nV + nC; j += gridDim.x) {
        if (j < nI) { for (int d = 0; d < 1 + ((PROBE_MIX >> 0) & 1); ++d) isel_item(p, j, smem); }
        else if (j < nI + nA) { for (int d = 0; d < 1 + ((PROBE_MIX >> 1) & 1); ++d) sgu_item(p, layer, j - nI, smem); }
        else if (j < nI + nA + nV) { for (int d = 0; d < 1 + ((PROBE_MIX >> 2) & 1); ++d) vt_item(p, j - nI - nA, smem); }
        else { for (int d = 0; d < 1 + ((PROBE_MIX >> 3) & 1); ++d) conv_item(p, layer, j - nI - nA - nV); }
    }
}

__device__ __forceinline__ int swap23(int i) { return (i & ~12) | ((i & 4) << 1) | ((i & 8) >> 1); }

__device__ __forceinline__ void phase_attn(const Params& p, unsigned char* smem) {
    const bf16_t* P = (const bf16_t*)(p.ws + WS_P); const bf16_t* VT = (const bf16_t*)(p.ws + WS_VT); bf16_t* YC = (bf16_t*)(p.ws + WS_YC);
    const unsigned long long* MK = (const unsigned long long*)(p.ws + WS_MASK);
    const int tid = otid(), lane = tid & 63, w = __builtin_amdgcn_readfirstlane(tid >> 6), hh = lane >> 5, l31 = lane & 31;
    constexpr int STG = 32768, KOFF = 0, VOFF = 16384;
    LAS unsigned char* lds = (LAS unsigned char*)smem;
    float* biasL = (float*)(smem + 3 * STG);
    constexpr float LOG2E = 1.4426950408889634f;
    const float sc = 0.08838834764831845f * LOG2E;
    int kro[2], vro[4];
#pragma unroll
    for (int c2 = 0; c2 < 2; ++c2) kro[c2] = (32 * c2 + swap23(l31)) * 256;
    const int krx = swap23(l31) & 15;
    const int vrx = (l31 >> 1) & 7;
#define ATT_WAIT_V(n) asm volatile("s_waitcnt vmcnt(" #n ")" ::: "memory")
#define ATT_ISSUE(kt_, stg_) do { const char* vg_ = (const char*)Vg + (size_t)(kt_) * 128; \
        int li_ = lane; asm volatile("" : "+v"(li_)); \
        _Pragma("unroll") for (int i_ = 0; i_ < 2; ++i_) { const int n_ = w + 8 * i_; \
            const int kr_ = 4 * n_ + (li_ >> 4), kc_ = (li_ & 15) ^ (kr_ & 15); const char* kga_ = (const char*)(P + pidx(b * SL + (kt_) * 64 + kr_, CK + h * 128 + kc_ * 8)); \
            const int vd_ = 8 * n_ + (li_ >> 3), vc_ = (li_ & 7) ^ ((vd_ >> 1) & 7); const unsigned vgo_ = (unsigned)(vd_ * SL * 2 + vc_ * 16); \
            __builtin_amdgcn_global_load_lds((const unsigned*)(kga_), (LAS unsigned*)(lds + (stg_) * STG + KOFF + n_ * 1024), 16, 0, 0); \
            __builtin_amdgcn_global_load_lds((const unsigned*)(vg_ + vgo_), (LAS unsigned*)(lds + (stg_) * STG + VOFF + n_ * 1024), 16, 0, 0); } } while (0)
    for (int item = blockIdx.x; item < 256; item += gridDim.x) {
        const int bh = (item & 7) + 8 * (item >> 6), pr = (item >> 3) & 7, b = bh >> 3, h = bh & 7;
        __syncthreads();
        if (tid < 129) { int bk = tid; if (tid >= 16) { bk = 16 + (int)(logf((float)tid * 0.0625f) / 2.0794415416798357f * 16.0f); bk = bk > 31 ? 31 : bk; } if (tid >= 128) bk = 31;
            biasL[tid] = (p.rel_bias[bk * 8 + h] - p.rel_bias[31 * 8 + h]) * LOG2E; }
        __syncthreads();
        const bf16_t* Vg = VT + (size_t)((b * 8 + h) * 128) * SL;
        for (int si = 0; si < 2; ++si) {
            const int qt = si ? pr : 15 - pr, q0 = qt * 256, tq = q0 + 32 * w + l31, tokq = b * SL + tq;
            const int nkt = (q0 + 256) >> 6, wlast = (q0 + 32 * w + 31) >> 6;
            bf16x8 Qf[8];
#pragma unroll
            for (int ks = 0; ks < 8; ++ks) { const u32x4 q4 = *(const u32x4*)(P + pidx(tokq, CQ + h * 128 + ks * 16 + hh * 8));
                u32x4 qs; qs.x = cvt_pk_bf16(bf_lo(q4.x) * sc, bf_hi(q4.x) * sc); qs.y = cvt_pk_bf16(bf_lo(q4.y) * sc, bf_hi(q4.y) * sc);
                qs.z = cvt_pk_bf16(bf_lo(q4.z) * sc, bf_hi(q4.z) * sc); qs.w = cvt_pk_bf16(bf_lo(q4.w) * sc, bf_hi(q4.w) * sc);
                __builtin_memcpy(&Qf[ks], &qs, 16); }
            const unsigned long long* mrow = MK + (size_t)tokq * 64;
            unsigned long long mnext = mrow[0];
            ATT_WAIT_V(0);
            ATT_ISSUE(0, 0);
            ATT_ISSUE(1, 1);
            f32x16 O[4];
#pragma unroll
            for (int dt = 0; dt < 4; ++dt) O[dt] = (f32x16){};
            float mrun = -1e30f, lsum = 0.f;
            int stg = 0;
            for (int kt = 0; kt < nkt; ++kt) {
                ATT_WAIT_V(4);
                __builtin_amdgcn_s_barrier();
                const unsigned long long mw = mnext;
                if (kt + 1 <= wlast) mnext = mrow[kt + 1];
                { const int k2 = (kt + 2 < nkt) ? kt + 2 : nkt - 1; const int s2 = (stg + 2 >= 3) ? stg - 1 : stg + 2; ATT_ISSUE(k2, s2); }
                if (kt <= wlast) {
                    LAS const unsigned char* Kc = lds + stg * STG + KOFF; LAS const unsigned char* Vc = lds + stg * STG + VOFF;
                    f32x16 sa[2];
#pragma unroll
                    for (int c2 = 0; c2 < 2; ++c2) {
                        sa[c2] = (f32x16){};
#pragma unroll
                        for (int ks = 0; ks < 8; ++ks) sa[c2] = __builtin_amdgcn_mfma_f32_32x32x16_bf16(*(LAS const bf16x8*)(Kc + kro[c2] + (((2 * ks + hh) ^ krx) << 4)), Qf[ks], sa[c2], 0, 0, 0);
                    }
                    const bool far = ((q0 + 32 * w) - (64 * kt + 63)) >= 128;
                    const int dist0 = tq - (64 * kt + 8 * hh);
                    const unsigned mlo = ((unsigned)mw) >> (8 * hh), mhi = ((unsigned)(mw >> 32)) >> (8 * hh);
                    if (!far) {
#pragma unroll
                        for (int c2 = 0; c2 < 2; ++c2)
#pragma unroll
                            for (int r = 0; r < 16; ++r) { int d = dist0 - (32 * c2 + 16 * (r >> 3) + (r & 7)); d = d < 0 ? 0 : (d > 128 ? 128 : d); sa[c2][r] += biasL[d]; }
                    }
                    float mx = fmaxf(sa[0][0], sa[1][0]);
#pragma unroll
                    for (int r = 1; r < 16; ++r) mx = fmaxf(fmaxf(mx, sa[0][r]), sa[1][r]);
                    mx = fmaxf(mx, __shfl_xor(mx, 32));
                    float alpha = 1.0f;
                    const bool grow = __ballot(mx > mrun + 8.0f) != 0ull;
                    if (grow) { const float mnew_ = fmaxf(mrun, mx); alpha = fast_exp2(mrun - mnew_); mrun = mnew_; }
                    const float mnew = mrun;
                    float ps = 0.f;
#pragma unroll
                    for (int c2 = 0; c2 < 2; ++c2)
#pragma unroll
                        for (int r = 0; r < 16; ++r) {
                            const int e = __builtin_amdgcn_sbfe((int)(c2 ? mhi : mlo), 16 * (r >> 3) + (r & 7), 1);
                            const float pv = __uint_as_float(__float_as_uint(fast_exp2(sa[c2][r] - mnew)) & (unsigned)e);
                            sa[c2][r] = pv; ps += pv; }
                    lsum = lsum * alpha + ps;
                    if (grow) {
#pragma unroll
                        for (int dt = 0; dt < 4; ++dt) O[dt] *= alpha;
                    }
#pragma unroll
                    for (int c2 = 0; c2 < 2; ++c2)
#pragma unroll
                        for (int c = 0; c < 2; ++c) {
                            u32x4 pw; pw.x = cvt_pk_bf16(sa[c2][8 * c + 0], sa[c2][8 * c + 1]); pw.y = cvt_pk_bf16(sa[c2][8 * c + 2], sa[c2][8 * c + 3]);
                            pw.z = cvt_pk_bf16(sa[c2][8 * c + 4], sa[c2][8 * c + 5]); pw.w = cvt_pk_bf16(sa[c2][8 * c + 6], sa[c2][8 * c + 7]);
                            bf16x8 Pf; __builtin_memcpy(&Pf, &pw, 16);
                            const int vch = ((4 * c2 + 2 * c + hh) ^ vrx) << 4;
#pragma unroll
                            for (int dt = 0; dt < 4; ++dt) O[dt] = __builtin_amdgcn_mfma_f32_32x32x16_bf16(*(LAS const bf16x8*)(Vc + (32 * dt + l31) * 128 + vch), Pf, O[dt], 0, 0, 0);
                        }
                }
                stg = (stg == 2) ? 0 : stg + 1;
            }
            ATT_WAIT_V(0);
            __builtin_amdgcn_s_barrier();
            lsum += __shfl_xor(lsum, 32);
            const float inv = 1.0f / lsum;
#pragma unroll
            for (int dt = 0; dt < 4; ++dt)
#pragma unroll
                for (int q4 = 0; q4 < 4; ++q4) {
                    const int d = h * 128 + 32 * dt + 8 * q4 + 4 * hh;
                    const u32x2 z4 = *(const u32x2*)(P + pidx(tokq, CZ + d));
                    const float y0 = O[dt][4 * q4 + 0] * inv * siluf_(bf_lo(z4.x)), y1 = O[dt][4 * q4 + 1] * inv * siluf_(bf_hi(z4.x));
                    const float y2 = O[dt][4 * q4 + 2] * inv * siluf_(bf_lo(z4.y)), y3 = O[dt][4 * q4 + 3] * inv * siluf_(bf_hi(z4.y));
                    u32x2 o; o.x = cvt_pk_bf16(y0, y1); o.y = cvt_pk_bf16(y2, y3);
                    *(u32x2*)(YC + (size_t)tokq * 1024 + d) = o;
                }
        }
    }
#undef ATT_WAIT_V
#undef ATT_ISSUE
}

#define XB_TMO      128
#define XB_XCNT(j)  (256  + 64 * (j))
#define XB_XSUB(j)  (1280 + 64 * (j))
#define XB_XGEN(j)  (2304 + 64 * (j))
#define XB_TOP      3328
#define XB_TOPGEN   3392
#define XCD_BAR_WORDS 3456
#define XB_SPIN_CAP (1u << 18)
__device__ __forceinline__ unsigned xb_ld(unsigned* p)              { return __hip_atomic_load(p, __ATOMIC_RELAXED, __HIP_MEMORY_SCOPE_AGENT); }
__device__ __forceinline__ unsigned xb_add(unsigned* p, unsigned v) { return __hip_atomic_fetch_add(p, v, __ATOMIC_RELAXED, __HIP_MEMORY_SCOPE_AGENT); }
__device__ __forceinline__ unsigned xb_xcc_id() { return (unsigned)__builtin_amdgcn_s_getreg((3 << 11) | 20) & 0xFu; }
#define XB_SPIN(cond, bar) do { unsigned _sp = 0; while (cond) { __builtin_amdgcn_s_sleep(1); \
    if ((++_sp & 255u) == 0u) { if (xb_ld(&(bar)[XB_TMO])) break; if (_sp > XB_SPIN_CAP) { atomicAdd(&(bar)[XB_TMO], 1u); break; } } } } while (0)
struct XcdBarrier { unsigned* bar; unsigned x; volatile LAS unsigned* st; };
__device__ __forceinline__ XcdBarrier xcd_barrier_post(unsigned* bar, volatile LAS unsigned* st) {
    XcdBarrier b; b.bar = bar; b.x = xb_xcc_id(); b.st = st;
    if (__builtin_amdgcn_workitem_id_x() == 0) (void)xb_add(&bar[XB_XCNT(b.x)], 1u);
    return b;
}
__device__ __forceinline__ void xcd_barrier_complete(unsigned* bar, unsigned x, unsigned& nloc, unsigned& nx) {
    const unsigned G = gridDim.x;
    unsigned sum, cnt, mine, sp = 0u;
    for (;;) {
        sum = 0u; cnt = 0u; mine = 0u;
#pragma unroll
        for (unsigned j = 0; j < 16; ++j) { const unsigned c = xb_ld(&bar[XB_XCNT(j)]); sum += c; cnt += (c > 0u) ? 1u : 0u; mine = (j == x) ? c : mine; }
        if (sum == G) break;
        __builtin_amdgcn_s_sleep(1);
        if ((++sp & 255u) == 0u) { if (xb_ld(&bar[XB_TMO])) break; if (sp > XB_SPIN_CAP) { atomicAdd(&bar[XB_TMO], 1u); break; } }
    }
    nloc = mine > 0u ? mine : 1u; nx = cnt > 0u ? cnt : 1u;
}
__device__ __forceinline__ void xcd_barrier(const XcdBarrier& b) {
    asm volatile("s_waitcnt vmcnt(0)" ::: "memory");
    __syncthreads();
    if (__builtin_amdgcn_workitem_id_x() == 0) {
        unsigned* bar = b.bar;
        __builtin_amdgcn_s_waitcnt(0);
        unsigned nloc = b.st[0], nx = b.st[1];
        if (nloc == 0u) { xcd_barrier_complete(bar, b.x, nloc, nx); b.st[0] = nloc; b.st[1] = nx; }
        const unsigned old = xb_add(&bar[XB_XSUB(b.x)], 1u);
        const unsigned gen = old / nloc;
        if (old + 1u == (gen + 1u) * nloc) {
            __builtin_amdgcn_fence(__ATOMIC_RELEASE, "agent");
            asm volatile("s_waitcnt vmcnt(0)" ::: "memory");
            const unsigned og = xb_add(&bar[XB_TOP], 1u);
            const unsigned tg = og / nx;
            if (og + 1u == (tg + 1u) * nx) xb_add(&bar[XB_TOPGEN], 1u);
            else XB_SPIN(xb_ld(&bar[XB_TOPGEN]) == tg, bar);
            __builtin_amdgcn_fence(__ATOMIC_ACQUIRE, "agent");
            xb_add(&bar[XB_XGEN(b.x)], 1u);
            asm volatile("s_waitcnt vmcnt(0)" ::: "memory");
        } else {
            XB_SPIN(xb_ld(&bar[XB_XGEN(b.x)]) == gen, bar);
            __builtin_amdgcn_fence(__ATOMIC_ACQUIRE, "agent");
            asm volatile("s_waitcnt vmcnt(0)" ::: "memory");
        }
    }
    __syncthreads();
}

__device__ __forceinline__ void gemm_call(const Params& p, int layer, int sub, int rep, unsigned char* smem) {
    LAS unsigned char* lds = (LAS unsigned char*)smem;
    bf16_t* H = (bf16_t*)(p.ws + WS_H); bf16_t* P = (bf16_t*)(p.ws + WS_P); float* X = (float*)(p.ws + WS_X);
    pg8::Gemm g; EpiAll E; pg8::StaticOrder S;
    E.O = P; E.ldc = NP; E.IKF = (bf16_t*)(p.ws + WS_IKF); E.sig_from = GA / 128; E.T = (float*)(p.ws + WS_T); E.Mout = (bf16_t*)(p.ws + WS_MM); E.Xin = (layer == 0) ? p.x : X; E.Xout = X; E.gcol0 = GA + rep * DM;
    g.M = MT;
    if (sub == 0) { g.A = H; g.Bt = (const bf16_t*)(p.ws + WS_WTIN + SZ_WTIN1 * layer); g.N = NP; g.K = DM; E.mode = 0; }
    else if (sub == 4) { g.A = (const bf16_t*)(p.ws + WS_YA + (size_t)rep * MT * 1024 * 2); g.Bt = (const bf16_t*)(p.ws + WS_WTPA + SZ_WTP1 * DEPTH * rep + SZ_WTP1 * layer); g.N = DM; g.K = 1024; E.mode = 1 + rep; }
    else { g.A = (const bf16_t*)(p.ws + WS_MM); g.Bt = (const bf16_t*)(p.ws + WS_WTO + SZ_WTO1 * layer); g.N = DM; g.K = DM; E.mode = 4; }
    S.init(MT, g.N, gridDim.x, blockIdx.x);
    pg8::gemm_phase(lds, g, S, E);
    __syncthreads();
}

#if MULTI_LAUNCH
__global__ void __launch_bounds__(512, 2) k_prep(Params p) { extern __shared__ __attribute__((aligned(16))) unsigned char smem[]; phase_prep(p, smem); }
__global__ void __launch_bounds__(512, 2) k_gemm(Params p, int layer, int sub, int rep) { extern __shared__ __attribute__((aligned(16))) unsigned char smem[]; gemm_call(p, layer, sub, rep, smem); }
__global__ void __launch_bounds__(512, 2) k_mix(Params p, int layer) { extern __shared__ __attribute__((aligned(16))) unsigned char smem[]; phase_mixprep(p, layer, smem); }
__global__ void __launch_bounds__(512, 2) k_attn(Params p) { extern __shared__ __attribute__((aligned(16))) unsigned char smem[]; phase_attn(p, smem); }
__global__ void __launch_bounds__(512, 2) k_norm(Params p, int layer) {
    float* X = (float*)(p.ws + WS_X);
    if (layer + 1 < DEPTH) rmsnorm_rows(X, p.norm_g + (size_t)(layer + 1) * DM, (bf16_t*)(p.ws + WS_H), nullptr);
    else rmsnorm_rows(X, p.final_g, nullptr, p.out);
}
#else
__global__ void __launch_bounds__(512, 2) fwd_megakernel(Params p) {
    extern __shared__ __attribute__((aligned(16))) unsigned char smem[];
    cg::grid_group grid = cg::this_grid();
    const int lo = p.ph_lo, hi = p.ph_hi;
    volatile LAS unsigned* xbst = (volatile LAS unsigned*)((LAS unsigned char*)smem + 131072);
    if (__builtin_amdgcn_workitem_id_x() == 0) { xbst[0] = 0u; xbst[1] = 0u; }
    __syncthreads();
    const XcdBarrier xbar = xcd_barrier_post((unsigned*)(p.ws + WS_BAR), xbst);
#define IN(k) (lo <= (k) && (k) < hi)
#define SEAM(k) do { if (IN(k) && IN((k) + 1)) { if ((k) == 0) grid.sync(); else xcd_barrier(xbar); } } while (0)
    for (int dup = 0; dup < 1 + ((PROBE_DUP >> 5) & 1); ++dup) { if (IN(0)) { phase_prep(p, smem); }
    SEAM(0); }
    for (int layer = 0; layer < DEPTH; ++layer) {
        const int b = 1 + 7 * layer;
        for (int dup = 0; dup < 1 + ((PROBE_DUP >> 0) & 1); ++dup) { if (IN(b + 0)) {
            gemm_call(p, layer, 0, 0, smem);
            const int nun = (MT / 256) * (NP / 256), rem = nun % (int)gridDim.x, idle = (int)gridDim.x - rem;
            if (layer + 1 < DEPTH && dup == 0) {
                if (rem == 0) convert_layer(p, (float*)smem, layer + 1, blockIdx.x, gridDim.x);
                else if ((int)blockIdx.x >= rem) convert_layer(p, (float*)smem, layer + 1, (int)blockIdx.x - rem, idle);
            } }
        SEAM(b + 0); }
        for (int dup = 0; dup < 1 + ((PROBE_DUP >> 1) & 1); ++dup) { if (IN(b + 1)) phase_mixprep(p, layer, smem);
        SEAM(b + 1); }
        for (int dup = 0; dup < 1 + ((PROBE_DUP >> 3) & 1); ++dup) { if (IN(b + 3)) phase_attn(p, smem);
        SEAM(b + 3); }
        for (int dup = 0; dup < 1 + ((PROBE_DUP >> 4) & 1); ++dup) { if (IN(b + 4)) { for (int rep = 0; rep < 3; ++rep) gemm_call(p, layer, 4, rep, smem); }
        SEAM(b + 4); }
        if (IN(b + 5)) gemm_call(p, layer, 5, 0, smem);
        SEAM(b + 5);
        if (IN(b + 6)) {
            float* X = (float*)(p.ws + WS_X);
            if (layer + 1 < DEPTH) rmsnorm_rows(X, p.norm_g + (size_t)(layer + 1) * DM, (bf16_t*)(p.ws + WS_H), nullptr);
            else rmsnorm_rows(X, p.final_g, nullptr, p.out);
        }
        SEAM(b + 6);
    }
#undef IN
#undef SEAM
}

#endif

extern "C" void kernel_launch(void* const* d_in, const int* in_sizes, int n_in, void* d_out, int out_size, void* d_ws, size_t ws_size, hipStream_t stream) {
    static int grid_blocks = 0;
    if (!grid_blocks) {
        if (n_in != 12 || out_size != MT * DM || ws_size < WS_END) { fprintf(stderr, "kernel_launch: unexpected shapes (n_in %d out %d ws %zu need %zu)\n", n_in, out_size, ws_size, (size_t)WS_END); grid_blocks = -1; return; }
        int dev = 0, cus = 0;
        (void)hipGetDevice(&dev);
        (void)hipDeviceGetAttribute(&cus, hipDeviceAttributeMultiprocessorCount, dev);
        bool ok = true;
#if MULTI_LAUNCH
        ok = ok && hipFuncSetAttribute((const void*)k_prep, hipFuncAttributeMaxDynamicSharedMemorySize, LDS_BYTES) == hipSuccess;
        ok = ok && hipFuncSetAttribute((const void*)k_gemm, hipFuncAttributeMaxDynamicSharedMemorySize, LDS_BYTES) == hipSuccess;
        ok = ok && hipFuncSetAttribute((const void*)k_mix, hipFuncAttributeMaxDynamicSharedMemorySize, LDS_BYTES) == hipSuccess;
        ok = ok && hipFuncSetAttribute((const void*)k_attn, hipFuncAttributeMaxDynamicSharedMemorySize, LDS_BYTES) == hipSuccess;
#else
        ok = ok && hipFuncSetAttribute((const void*)fwd_megakernel, hipFuncAttributeMaxDynamicSharedMemorySize, LDS_BYTES) == hipSuccess;
        int per_cu = 0;
        (void)hipOccupancyMaxActiveBlocksPerMultiprocessor(&per_cu, (const void*)fwd_megakernel, 512, LDS_BYTES);
        if (per_cu < 1) fprintf(stderr, "kernel_launch: occupancy query says %d blocks per CU\n", per_cu);
#endif
        if (!ok) { fprintf(stderr, "kernel_launch: hipFuncSetAttribute failed\n"); grid_blocks = -1; return; }
        grid_blocks = cus > 0 ? cus : 256;
    }
    if (grid_blocks < 0) return;
    Params p{};
    p.x = (const float*)d_in[0]; p.norm_g = (const float*)d_in[1]; p.w_in = (const float*)d_in[2]; p.a_ws = (const float*)d_in[3]; p.a_b = (const float*)d_in[4];
    p.b_conv = (const float*)d_in[5]; p.p_a = (const float*)d_in[6]; p.p_b = (const float*)d_in[7]; p.p_c = (const float*)d_in[8]; p.w_o = (const float*)d_in[9];
    p.rel_bias = (const float*)d_in[10]; p.final_g = (const float*)d_in[11];
    p.out = (float*)d_out; p.ws = (unsigned char*)d_ws;
#if MULTI_LAUNCH
    const dim3 G(grid_blocks), B(512);
    hipLaunchKernelGGL(k_prep, G, B, LDS_BYTES, stream, p);
    for (int layer = 0; layer < DEPTH; ++layer) {
        hipLaunchKernelGGL(k_gemm, G, B, LDS_BYTES, stream, p, layer, 0, 0);
        hipLaunchKernelGGL(k_mix, G, B, LDS_BYTES, stream, p, layer);
        hipLaunchKernelGGL(k_attn, G, B, LDS_BYTES, stream, p);
        for (int rep = 0; rep < 3; ++rep) hipLaunchKernelGGL(k_gemm, G, B, LDS_BYTES, stream, p, layer, 4, rep);
        hipLaunchKernelGGL(k_gemm, G, B, LDS_BYTES, stream, p, layer, 5, 0);
        hipLaunchKernelGGL(k_norm, G, B, 0, stream, p, layer);
    }
#else
    p.ph_lo = 0; p.ph_hi = NPHASES;
    (void)hipMemsetAsync((unsigned char*)d_ws + WS_BAR, 0, 16384, stream);
    void* args[] = {&p};
    hipError_t e = hipLaunchCooperativeKernel((const void*)fwd_megakernel, dim3(grid_blocks), dim3(512), args, LDS_BYTES, stream);
    if (e != hipSuccess) fprintf(stderr, "cooperative launch failed: %s (grid %d)\n", hipGetErrorString(e), grid_blocks);
#endif
}
```

```cpp
#include <hip/hip_runtime.h>
#include <hip/hip_cooperative_groups.h>
#include <cstdio>
#include <cmath>
namespace cg = cooperative_groups;

#ifndef MULTI_LAUNCH
#define MULTI_LAUNCH 0
#endif

#ifndef PROBE_MIX
#define PROBE_MIX 0
#endif
#ifndef PROBE_DUP
#define PROBE_DUP 0
#endif
#define LAS __attribute__((address_space(3)))
typedef unsigned short bf16_t;
typedef short bf16x8 __attribute__((ext_vector_type(8)));
typedef float f32x4 __attribute__((ext_vector_type(4)));
typedef float f32x16 __attribute__((ext_vector_type(16)));
typedef unsigned u32x4 __attribute__((ext_vector_type(4)));
typedef unsigned u32x2 __attribute__((ext_vector_type(2)));

constexpr int DM = 2048, NB = 4, SL = 4096, DEPTH = 4, MT = NB * SL;
constexpr int INC = 18512;
constexpr int NP = 18688;
constexpr int AU = 0, AV = 1024, AZ = 2048, BB = 3072, BC = 4096, BX = 5120, BZ = 6144, CQ = 7168, CK = 8192, CV = 9216, CZ = 10240,
              IQ = 11264, IK = 12288, IW = 12352, GA = 12416, GB = 14464, GC = 16512;
constexpr int NPHASES = 1 + 7 * DEPTH;

constexpr size_t WS_WTIN = 0;
constexpr size_t SZ_WTIN1 = (size_t)NP * DM * 2;
constexpr size_t WS_WTPA = WS_WTIN + SZ_WTIN1 * DEPTH;
constexpr size_t SZ_WTP1 = (size_t)DM * 1024 * 2;
constexpr size_t WS_WTPB = WS_WTPA + SZ_WTP1 * DEPTH;
constexpr size_t WS_WTPC = WS_WTPB + SZ_WTP1 * DEPTH;
constexpr size_t WS_WTO = WS_WTPC + SZ_WTP1 * DEPTH;
constexpr size_t SZ_WTO1 = (size_t)DM * DM * 2;
constexpr size_t WS_AWS = WS_WTO + SZ_WTO1 * DEPTH;
constexpr size_t SZ_AWS1 = (size_t)8 * 128 * 128 * 2;
constexpr size_t WS_H = WS_AWS + SZ_AWS1 * DEPTH;
constexpr size_t WS_P = WS_H + (size_t)MT * DM * 2;
constexpr size_t WS_X = WS_P + (size_t)MT * NP * 2;
constexpr size_t WS_YA = WS_X + (size_t)MT * DM * 4;
constexpr size_t WS_YB = WS_YA + (size_t)MT * 1024 * 2;
constexpr size_t WS_YC = WS_YB + (size_t)MT * 1024 * 2;
constexpr size_t WS_T = WS_YC + (size_t)MT * 1024 * 2;
constexpr size_t WS_MM = WS_T + (size_t)MT * DM * 4;
constexpr size_t WS_S = WS_MM + (size_t)MT * DM * 2;
constexpr size_t WS_MASK = WS_S + (size_t)MT * SL * 4;
constexpr size_t WS_VT = WS_MASK + (size_t)MT * 64 * 8;
constexpr size_t WS_BAR = WS_VT + (size_t)MT * 1024 * 2;
constexpr size_t WS_END = WS_BAR + 16384;

constexpr size_t WS_IKF = WS_S;
constexpr int LDS_BYTES = 131072 + 64;

struct Params {
    const float *x, *norm_g, *w_in, *a_ws, *a_b, *b_conv, *p_a, *p_b, *p_c, *w_o, *rel_bias, *final_g;
    float* out;
    unsigned char* ws;
    int ph_lo, ph_hi;
};

__device__ __forceinline__ size_t pidx(int tok, int col) { return ((size_t)((tok >> 8) * (NP / 256) + (col >> 8)) << 16) + (size_t)(((tok & 255) << 8) + (col & 255)); }
__device__ __forceinline__ unsigned cvt_pk_bf16(float lo, float hi) { unsigned r; asm("v_cvt_pk_bf16_f32 %0, %1, %2" : "=v"(r) : "v"(lo), "v"(hi)); return r; }
__device__ __forceinline__ int otid() { int t = __builtin_amdgcn_workitem_id_x(); asm volatile("" : "+v"(t)); return t; }
__device__ __forceinline__ float bf_lo(unsigned w) { return __uint_as_float(w << 16); }
__device__ __forceinline__ float bf_hi(unsigned w) { return __uint_as_float(w & 0xffff0000u); }
__device__ __forceinline__ float bf2f(bf16_t b) { return __uint_as_float(((unsigned)b) << 16); }
__device__ __forceinline__ float fast_exp2(float x) { return __builtin_amdgcn_exp2f(x); }
__device__ __forceinline__ float sigmoidf_(float x) { return __builtin_amdgcn_rcpf(1.0f + __expf(-x)); }
__device__ __forceinline__ float siluf_(float x) { return x * sigmoidf_(x); }

namespace pg8 {
constexpr int BM = 256, BK = 64, HALF = 128, HTB = HALF * BK * 2, STAGE_BYTES = 8 * HTB, NXCD = 8, WGM = 8;
__host__ __device__ __forceinline__ int lds_byte(int r, int c) { const int st = (r >> 4) * 2 + (c >> 5), rr = r & 15, cc = c & 31, ob = rr * 64 + cc * 2; return st * 1024 + (ob ^ (((ob >> 9) & 1) << 5)); }
__host__ __device__ __forceinline__ void stage_rc(int b, int& R, int& C) { const int st = b / 1024, sb = b % 1024, swz = sb ^ (((sb >> 9) & 1) << 5); R = (st >> 1) * 16 + swz / 64; C = (st & 1) * 32 + (swz % 64) / 2; }
__host__ __device__ __forceinline__ int perm32(int rho) { const int n = rho >> 4, i = rho & 15; return 8 * (i >> 2) + 4 * n + (i & 3); }
struct Unit { int pm, pn; };
struct Gemm { const bf16_t* A; const bf16_t* Bt; int M, N, K; };
struct StaticOrder {
    int nM, nN, nwg, G, c;
    __host__ __device__ void init(int M, int N, int G_, int c_) { nM = M / BM; nN = N / BM; nwg = nM * nN; G = G_; c = c_; }
    __host__ __device__ bool next(int i, Unit& u) const {
        const int L = i * G + c; if (L >= nwg) return false;
        const int wgid = (L & 7) * (nwg >> 3) + (L >> 3);
        int gid, within;
        if (nN == 8) { gid = wgid >> 6; within = wgid & 63; } else { gid = wgid / 584; within = wgid - gid * 584; }
        u.pm = gid * 8 + (within & 7); u.pn = within >> 3; return true;
    }
};

template <class Epi>
__device__ __forceinline__ void gemm_phase(LAS unsigned char* lds, const Gemm g, const StaticOrder& S, const Epi& E) {
    const int tid = otid(), wid = __builtin_amdgcn_readfirstlane(tid >> 6), lane = tid & 63, wr = wid >> 2, wc = wid & 3, fr = lane & 15, fq = lane >> 4;
    const int K = g.K, nt = K / BK;
    unsigned voffA[2], voffB[2];
#pragma unroll
    for (int i = 0; i < 2; ++i) { int R, C; stage_rc(tid * 16 + i * 8192, R, C); const int Rb = (R & ~31) + perm32(R & 31);
        (void)R; (void)C; (void)Rb; voffA[i] = (unsigned)(tid * 16 + i * 8192); voffB[i] = voffA[i]; }
    const size_t kstep = (size_t)32768;
    const size_t hstep = (size_t)16384;
    const size_t tstep = (size_t)(K / BK) * kstep;
    const unsigned ldsw = (unsigned)wid * 1024u;
    const int aoff = lds_byte(wr * 64 + fr, fq * 8), boff = lds_byte(wc * 32 + fr, fq * 8);
#define PG8_SA(b, h) (((b) * 2 + (h)) * HTB)
#define PG8_SB(b, h) ((4 + (b) * 2 + (h)) * HTB)
#define PG8_STAGE(bufoff, gbase, voff) do { _Pragma("unroll") for (int _i = 0; _i < 2; ++_i) \
        __builtin_amdgcn_global_load_lds((const unsigned*)((const char*)(gbase) + (voff)[_i]), (LAS unsigned*)(lds + (bufoff) + ldsw + _i * 8192), 16, 0, 0); } while (0)
#define PG8_LDA(dst, b, h) do { _Pragma("unroll") for (int m = 0; m < 4; ++m) _Pragma("unroll") for (int k = 0; k < 2; ++k) dst[m][k] = *(const LAS bf16x8*)(lds + PG8_SA(b, h) + aoff + m * 2048 + k * 1024); } while (0)
#define PG8_LDB(dst, b, h) do { _Pragma("unroll") for (int n = 0; n < 2; ++n) _Pragma("unroll") for (int k = 0; k < 2; ++k) dst[n][k] = *(const LAS bf16x8*)(lds + PG8_SB(b, h) + boff + n * 2048 + k * 1024); } while (0)
#define PG8_MMA(ai, bj, At, Bt) do { __builtin_amdgcn_s_setprio(1); _Pragma("unroll") for (int m = 0; m < 4; ++m) _Pragma("unroll") for (int n = 0; n < 2; ++n) _Pragma("unroll") for (int k = 0; k < 2; ++k) \
        acc[ai][bj][m][n] = __builtin_amdgcn_mfma_f32_16x16x32_bf16(Bt[n][k], At[m][k], acc[ai][bj][m][n], 0, 0, 0); __builtin_amdgcn_s_setprio(0); } while (0)
#define PG8_WAIT_V(n) asm volatile("s_waitcnt vmcnt(" #n ")" ::: "memory")
#define PG8_WAIT_L(n) asm volatile("s_waitcnt lgkmcnt(" #n ")" ::: "memory")
#define PG8_BAR __builtin_amdgcn_s_barrier()
#define PG8_SCHED __builtin_amdgcn_sched_barrier(0)
    Unit cur, nxt; int ui = 0;
    if (!S.next(0, cur)) return;
    f32x4 acc[2][2][4][2];
#pragma unroll
    for (int a = 0; a < 2; ++a)
#pragma unroll
        for (int b = 0; b < 2; ++b)
#pragma unroll
            for (int m = 0; m < 4; ++m)
#pragma unroll
                for (int n = 0; n < 2; ++n) acc[a][b][m][n] = (f32x4){0.f, 0.f, 0.f, 0.f};
    bf16x8 At[4][2], B0[2][2], B1[2][2];
    const char* cA = (const char*)g.A + (size_t)cur.pm * tstep; const char* cB = (const char*)g.Bt + (size_t)cur.pn * tstep;
    PG8_STAGE(PG8_SB(0, 0), cB, voffB); PG8_STAGE(PG8_SB(0, 1), cB + hstep, voffB); PG8_STAGE(PG8_SA(0, 0), cA, voffA); PG8_STAGE(PG8_SA(0, 1), cA + hstep, voffA);
    if (wr == 1) PG8_BAR;
    PG8_WAIT_V(2); PG8_BAR;
    PG8_STAGE(PG8_SB(1, 0), cB + kstep, voffB); PG8_STAGE(PG8_SA(1, 0), cA + kstep, voffA); PG8_STAGE(PG8_SB(1, 1), cB + hstep + kstep, voffB);
    PG8_WAIT_V(6); PG8_BAR;
    for (;;) {
        const bool has_next = S.next(ui + 1, nxt);
        const char* nA = has_next ? (const char*)g.A + (size_t)nxt.pm * tstep : cA; const char* nB = has_next ? (const char*)g.Bt + (size_t)nxt.pn * tstep : cB;
        for (int t = 0; t < nt; t += 2) {
            const bool last = (t == nt - 2);
            const char* a1 = cA + (size_t)(t + 1) * kstep;
            const char* a2 = last ? nA : cA + (size_t)(t + 2) * kstep; const char* b2 = last ? nB : cB + (size_t)(t + 2) * kstep;
            const char* a3 = a2 + kstep; const char* b3 = b2 + kstep;
            PG8_LDB(B0, 0, 0); PG8_LDB(B1, 0, 1); PG8_SCHED; PG8_LDA(At, 0, 0); PG8_STAGE(PG8_SA(1, 1), a1 + hstep, voffA);
            PG8_WAIT_V(8); PG8_WAIT_L(0); PG8_BAR; PG8_MMA(0, 0, At, B0); PG8_MMA(0, 1, At, B1); PG8_BAR; PG8_SCHED;
            PG8_LDA(At, 0, 1); PG8_STAGE(PG8_SB(0, 0), b2, voffB); PG8_STAGE(PG8_SB(0, 1), b2 + hstep, voffB); PG8_STAGE(PG8_SA(0, 0), a2, voffA);
            PG8_WAIT_V(8); PG8_WAIT_L(0); PG8_BAR; PG8_MMA(1, 0, At, B0); PG8_MMA(1, 1, At, B1); PG8_BAR; PG8_SCHED;
            PG8_LDB(B0, 1, 0); PG8_LDB(B1, 1, 1); PG8_SCHED; PG8_LDA(At, 1, 0); PG8_STAGE(PG8_SA(0, 1), a2 + hstep, voffA);
            PG8_WAIT_V(8); PG8_WAIT_L(0); PG8_BAR; PG8_MMA(0, 0, At, B0); PG8_MMA(0, 1, At, B1); PG8_BAR; PG8_SCHED;
            PG8_LDA(At, 1, 1); PG8_STAGE(PG8_SB(1, 0), b3, voffB); PG8_STAGE(PG8_SB(1, 1), b3 + hstep, voffB); PG8_STAGE(PG8_SA(1, 0), a3, voffA);
            PG8_WAIT_V(8); PG8_WAIT_L(0); PG8_BAR; PG8_MMA(1, 0, At, B0); PG8_MMA(1, 1, At, B1); PG8_BAR; PG8_SCHED;
        }
        if (wr == 0) PG8_BAR;
        E(acc, cur, wr, wc, fr, fq);
        if (!has_next) break;
#pragma unroll
        for (int a = 0; a < 2; ++a)
#pragma unroll
            for (int b = 0; b < 2; ++b)
#pragma unroll
                for (int m = 0; m < 4; ++m)
#pragma unroll
                    for (int n = 0; n < 2; ++n) acc[a][b][m][n] = (f32x4){0.f, 0.f, 0.f, 0.f};
        cur = nxt; cA = nA; cB = nB; ++ui;
        if (wr == 1) PG8_BAR;
    }
    PG8_WAIT_V(0);
    PG8_BAR;
#undef PG8_SA
#undef PG8_SB
#undef PG8_STAGE
#undef PG8_LDA
#undef PG8_LDB
#undef PG8_MMA
#undef PG8_WAIT_V
#undef PG8_WAIT_L
#undef PG8_BAR
#undef PG8_SCHED
}
}

__device__ __forceinline__ size_t oidx(int row, int k, int K, bool permB) {
    int r = row & 127;
    if (permB) { const int c32 = r & 31; r = (r & ~31) + 16 * ((c32 >> 2) & 1) + 4 * (c32 >> 3) + (c32 & 3); }
    const size_t blk = ((size_t)(row >> 8) * (K >> 6) + (k >> 6)) * 2 + ((row >> 7) & 1);
    return blk * 8192 + (size_t)(pg8::lds_byte(r, k & 63) >> 1);
}

struct EpiAll {
    int mode; bf16_t* O; int ldc; int sig_from; int gcol0; float* T; bf16_t* Mout; const float* Xin; float* Xout; bf16_t* IKF;
    __device__ __forceinline__ void operator()(const f32x4 (&acc)[2][2][4][2], const pg8::Unit& u, int wr, int wc, int fr, int fq) const {
        const int row0 = u.pm * 256 + wr * 64 + fr, col0 = u.pn * 256 + wc * 32 + 8 * fq;
        if (mode == 0) {
            for (int dup_ = 0; dup_ < 1 + ((PROBE_DUP >> 7) & 1); ++dup_)
#pragma unroll
            for (int bj = 0; bj < 2; ++bj) {
                const bool sg = (u.pn * 2 + bj) >= sig_from;
                const int col = col0 + bj * 128;
#pragma unroll
                for (int ai = 0; ai < 2; ++ai)
#pragma unroll
                    for (int m = 0; m < 4; ++m) { const size_t row = (size_t)(row0 + ai * 128 + m * 16);
                        f32x4 v0 = acc[ai][bj][m][0], v1 = acc[ai][bj][m][1];
                        if (sg) {
#pragma unroll
                            for (int j = 0; j < 4; ++j) { v0[j] = sigmoidf_(v0[j]); v1[j] = sigmoidf_(v1[j]); } }
                        u32x4 w; w.x = cvt_pk_bf16(v0[0], v0[1]); w.y = cvt_pk_bf16(v0[2], v0[3]); w.z = cvt_pk_bf16(v1[0], v1[1]); w.w = cvt_pk_bf16(v1[2], v1[3]);
                        *(u32x4*)(O + pidx((int)row, col)) = w;
                        if (col >= IK && col < IK + 64) {
                            const int kg = (col - IK) >> 3;
                            *(u32x4*)(IKF + ((row >> 5) * 4 + (kg >> 1)) * 512 + (((int)row & 31) + 32 * (kg & 1)) * 8) = w; }
                    }
            }
        } else if (mode <= 3) {
            u32x4 gw[2], tw[2], gn[2], tn[2], gm[2], tm[2];
#define EPI_LD(s_, G_, T_) do { const int bj_ = (s_) >> 2, ai_ = ((s_) >> 1) & 1, mb_ = ((s_) & 1) * 2; \
                _Pragma("unroll") for (int mm = 0; mm < 2; ++mm) { const size_t row = (size_t)(row0 + ai_ * 128 + (mb_ + mm) * 16); const int col = col0 + bj_ * 128; \
                    G_[mm] = *(const u32x4*)(O + pidx((int)row, gcol0 + col)); if (mode >= 2) T_[mm] = *(const u32x4*)(Mout + oidx((int)row, col, DM, false)); } } while (0)
            EPI_LD(0, gw, tw); EPI_LD(1, gn, tn);
#pragma unroll
            for (int s = 0; s < 8; ++s) { const int bj = s >> 2, ai = (s >> 1) & 1, mb = (s & 1) * 2, col = col0 + bj * 128;
                if (s < 6) EPI_LD(s + 2, gm, tm);
                asm volatile("" ::: "memory");
#pragma unroll
                for (int mm = 0; mm < 2; ++mm) { const int m = mb + mm; const size_t row = (size_t)(row0 + ai * 128 + m * 16);
                    f32x4 v0 = acc[ai][bj][m][0], v1 = acc[ai][bj][m][1];
                    v0[0] *= bf_lo(gw[mm].x); v0[1] *= bf_hi(gw[mm].x); v0[2] *= bf_lo(gw[mm].y); v0[3] *= bf_hi(gw[mm].y);
                    v1[0] *= bf_lo(gw[mm].z); v1[1] *= bf_hi(gw[mm].z); v1[2] *= bf_lo(gw[mm].w); v1[3] *= bf_hi(gw[mm].w);
                    if (mode >= 2) { v0[0] += bf_lo(tw[mm].x); v0[1] += bf_hi(tw[mm].x); v0[2] += bf_lo(tw[mm].y); v0[3] += bf_hi(tw[mm].y);
                        v1[0] += bf_lo(tw[mm].z); v1[1] += bf_hi(tw[mm].z); v1[2] += bf_lo(tw[mm].w); v1[3] += bf_hi(tw[mm].w); }
                    u32x4 w; w.x = cvt_pk_bf16(v0[0], v0[1]); w.y = cvt_pk_bf16(v0[2], v0[3]); w.z = cvt_pk_bf16(v1[0], v1[1]); w.w = cvt_pk_bf16(v1[2], v1[3]);
                    *(u32x4*)(Mout + oidx((int)row, col, DM, false)) = w; }
                asm volatile("" ::: "memory");
#pragma unroll
                for (int mm = 0; mm < 2; ++mm) { gw[mm] = gn[mm]; tw[mm] = tn[mm]; gn[mm] = gm[mm]; tn[mm] = tm[mm]; }
            }
#undef EPI_LD
        } else {
            f32x4 xa[2], xb[2], xan[2], xbn[2];
#define EPI_LD(s_, A_, B_) do { const int bj_ = (s_) >> 2, ai_ = ((s_) >> 1) & 1, mb_ = ((s_) & 1) * 2; \
                _Pragma("unroll") for (int mm = 0; mm < 2; ++mm) { const size_t o = (size_t)(row0 + ai_ * 128 + (mb_ + mm) * 16) * DM + col0 + bj_ * 128; \
                    A_[mm] = *(const f32x4*)(Xin + o); B_[mm] = *(const f32x4*)(Xin + o + 4); } } while (0)
            EPI_LD(0, xa, xb);
#pragma unroll
            for (int s = 0; s < 8; ++s) { const int bj = s >> 2, ai = (s >> 1) & 1, mb = (s & 1) * 2;
                if (s < 7) EPI_LD(s + 1, xan, xbn);
                asm volatile("" ::: "memory");
#pragma unroll
                for (int mm = 0; mm < 2; ++mm) { const size_t o = (size_t)(row0 + ai * 128 + (mb + mm) * 16) * DM + col0 + bj * 128;
                    *(f32x4*)(Xout + o) = xa[mm] + acc[ai][bj][mb + mm][0]; *(f32x4*)(Xout + o + 4) = xb[mm] + acc[ai][bj][mb + mm][1]; }
                asm volatile("" ::: "memory");
#pragma unroll
                for (int mm = 0; mm < 2; ++mm) { xa[mm] = xan[mm]; xb[mm] = xbn[mm]; }
            }
#undef EPI_LD
        }
    }
};

__device__ __forceinline__ void tcvt_load(const float* __restrict__ src, int ld_src, int k0, int n0, int mode, f32x4 (&v)[2]) {
    const int tid = otid();
#pragma unroll
    for (int i = 0; i < 2; ++i) {
        const int idx = tid + 512 * i, kk = idx >> 4, nq = idx & 15, n = n0 + 4 * nq;
        int sc = n; bool valid = true;
        if (mode == 1) { if (n < 12368) sc = n; else if (n < 12416) valid = false; else if (n < 18560) sc = n - 48; else valid = false; }
        v[i] = (f32x4){0.f, 0.f, 0.f, 0.f};
        if (valid) v[i] = *(const f32x4*)(src + (size_t)(k0 + kk) * ld_src + sc);
    }
}
__device__ __forceinline__ void tcvt_lds_write(const f32x4 (&v)[2], float* tile) {
    const int tid = otid();
#pragma unroll
    for (int i = 0; i < 2; ++i) { const int idx = tid + 512 * i, kk = idx >> 4, nq = idx & 15;
        float* tp = tile + kk * 65 + 4 * nq; tp[0] = v[i][0]; tp[1] = v[i][1]; tp[2] = v[i][2]; tp[3] = v[i][3]; }
}
__device__ __forceinline__ void tcvt_store(bf16_t* __restrict__ dst, int K, int k0, int n0, const float* tile) {
    const int tid = otid();
    const int n = tid >> 3, kc = tid & 7; const float* tp = tile + (kc * 8) * 65 + n;
    u32x4 w; w.x = cvt_pk_bf16(tp[0], tp[65]); w.y = cvt_pk_bf16(tp[130], tp[195]); w.z = cvt_pk_bf16(tp[260], tp[325]); w.w = cvt_pk_bf16(tp[390], tp[455]);
    *(u32x4*)(dst + oidx(n0 + n, k0 + kc * 8, K, true)) = w;
}

__device__ __forceinline__ void rmsnorm_rows(const float* __restrict__ X, const float* __restrict__ g, bf16_t* __restrict__ H, float* __restrict__ Out) {
    const int lane = otid() & 63, gw = blockIdx.x * 8 + (otid() >> 6), nw = gridDim.x * 8;
    for (int row = gw; row < MT; row += nw) {
        const f32x4* xr = (const f32x4*)(X + (size_t)row * DM);
        f32x4 v[8]; float ss = 0.f;
#pragma unroll
        for (int i = 0; i < 8; ++i) { v[i] = xr[lane + 64 * i]; ss += v[i][0] * v[i][0] + v[i][1] * v[i][1] + v[i][2] * v[i][2] + v[i][3] * v[i][3]; }
#pragma unroll
        for (int o = 32; o >= 1; o >>= 1) ss += __shfl_xor(ss, o);
        const float rstd = rsqrtf(ss * (1.0f / DM) + 1e-6f);
#pragma unroll
        for (int i = 0; i < 8; ++i) { const f32x4 gg = *(const f32x4*)(g + 4 * (lane + 64 * i));
            const float a = v[i][0] * rstd * gg[0], b = v[i][1] * rstd * gg[1], c = v[i][2] * rstd * gg[2], d = v[i][3] * rstd * gg[3];
            if (H) { u32x2 w; w.x = cvt_pk_bf16(a, b); w.y = cvt_pk_bf16(c, d); *(u32x2*)(H + oidx(row, 4 * (lane + 64 * i), DM, false)) = w; }
            else { *(f32x4*)(Out + (size_t)row * DM + 4 * (lane + 64 * i)) = (f32x4){a, b, c, d}; } }
    }
}

__device__ __forceinline__ void convert_layer(const Params& p, float* tile, int l, int bid, int nb) {
    int base = 0;
    for (int kind = 0; kind < 5; ++kind) {
        const float* src; bf16_t* dst; int ld_src, K, ntn, mode = 0;
        if (kind == 0) { src = p.w_in + (size_t)l * DM * INC; dst = (bf16_t*)(p.ws + WS_WTIN + SZ_WTIN1 * l); ld_src = INC; K = DM; ntn = NP / 64; mode = 1; }
        else if (kind == 4) { src = p.w_o + (size_t)l * DM * DM; dst = (bf16_t*)(p.ws + WS_WTO + SZ_WTO1 * l); ld_src = DM; K = DM; ntn = DM / 64; }
        else { const float* s3 = kind == 1 ? p.p_a : (kind == 2 ? p.p_b : p.p_c); const size_t o3 = kind == 1 ? WS_WTPA : (kind == 2 ? WS_WTPB : WS_WTPC);
            src = s3 + (size_t)l * 1024 * DM; dst = (bf16_t*)(p.ws + o3 + SZ_WTP1 * l); ld_src = DM; K = 1024; ntn = DM / 64; }
        const int cnt = ntn * (K / 64);
        int first = (bid - base) % nb; if (first < 0) first += nb;
        f32x4 v[2];
        if (first < cnt) tcvt_load(src, ld_src, (first / ntn) * 64, (first % ntn) * 64, mode, v);
        for (int j = first; j < cnt; j += nb) {
            const int kt = j / ntn, nt = j % ntn;
            tcvt_lds_write(v, tile);
            __syncthreads();
            if (j + nb < cnt) tcvt_load(src, ld_src, ((j + nb) / ntn) * 64, ((j + nb) % ntn) * 64, mode, v);
            tcvt_store(dst, K, kt * 64, nt * 64, tile);
            __syncthreads();
        }
        base += cnt;
    }
}

__device__ __forceinline__ void phase_prep(const Params& p, unsigned char* smem) {
    float* tile = (float*)smem;
    const int bid = blockIdx.x, nb = gridDim.x;
    convert_layer(p, tile, 0, bid, nb);
    { bf16_t* aw = (bf16_t*)(p.ws + WS_AWS); const int n = DEPTH * 8 * 128 * 128;
      for (int i = bid * 512 + otid(); i < n; i += nb * 512) { const int s = i & 127, t = (i >> 7) & 127; const float v = (s <= t) ? p.a_ws[i] : 0.f; aw[i] = (bf16_t)(cvt_pk_bf16(v, 0.f) & 0xffffu); } }
    rmsnorm_rows(p.x, p.norm_g, (bf16_t*)(p.ws + WS_H), nullptr);
}

__device__ __forceinline__ void isel_item(const Params& p, int item, unsigned char* smem) {
    const bf16_t* P = (const bf16_t*)(p.ws + WS_P); unsigned long long* MK = (unsigned long long*)(p.ws + WS_MASK);
    unsigned* SU = (unsigned*)smem;
    const int tid = otid(), lane = tid & 63, w = __builtin_amdgcn_readfirstlane(tid >> 6), hh = lane >> 5, l31 = lane & 31;
    const int b = item >> 9, t0 = (((item >> 8) & 1) ? 511 - (item & 255) : (item & 255)) * 8;
    const int nkt = ((t0 + 7) >> 5) + 1;
    {
        bf16x8 Af[4][4]; float wv[4][16];
        const int qq = (l31 >> 2) & 1, hd = (l31 & 3) + 4 * (l31 >> 3);
#pragma unroll
        for (int rt = 0; rt < 4; ++rt) { const bf16_t* bp = P + pidx(b * SL + t0 + 2 * rt + qq, IQ + hd * 64 + hh * 8);
#pragma unroll
            for (int ks = 0; ks < 4; ++ks) Af[rt][ks] = *(const bf16x8*)(bp + ks * 16);
            const u32x4* wp = (const u32x4*)(P + pidx(b * SL + t0 + 2 * rt + hh, IW));
            const u32x4 w0 = wp[0], w1 = wp[1];
            const float sc = 1.0f / 32.0f;
            wv[rt][0] = bf_lo(w0.x) * sc; wv[rt][1] = bf_hi(w0.x) * sc; wv[rt][2] = bf_lo(w0.y) * sc; wv[rt][3] = bf_hi(w0.y) * sc;
            wv[rt][4] = bf_lo(w0.z) * sc; wv[rt][5] = bf_hi(w0.z) * sc; wv[rt][6] = bf_lo(w0.w) * sc; wv[rt][7] = bf_hi(w0.w) * sc;
            wv[rt][8] = bf_lo(w1.x) * sc; wv[rt][9] = bf_hi(w1.x) * sc; wv[rt][10] = bf_lo(w1.y) * sc; wv[rt][11] = bf_hi(w1.y) * sc;
            wv[rt][12] = bf_lo(w1.z) * sc; wv[rt][13] = bf_hi(w1.z) * sc; wv[rt][14] = bf_lo(w1.w) * sc; wv[rt][15] = bf_hi(w1.w) * sc; }
        const bf16_t* kb = (const bf16_t*)(p.ws + WS_IKF) + (size_t)(b * (SL / 32)) * 2048 + lane * 8;
        bf16x8 Bf[4];
        if (w < nkt) {
#pragma unroll
            for (int ks = 0; ks < 4; ++ks) Bf[ks] = *(const bf16x8*)(kb + (size_t)w * 2048 + ks * 512);
        }
        for (int j = w; j < nkt; j += 8) {
            f32x16 acc[4];
#pragma unroll
            for (int rt = 0; rt < 4; ++rt) acc[rt] = (f32x16){};
#pragma unroll
            for (int ks = 0; ks < 4; ++ks)
#pragma unroll
                for (int rt = 0; rt < 4; ++rt) acc[rt] = __builtin_amdgcn_mfma_f32_32x32x16_bf16(Af[rt][ks], Bf[ks], acc[rt], 0, 0, 0);
            if (j + 8 < nkt) {
#pragma unroll
                for (int ks = 0; ks < 4; ++ks) Bf[ks] = *(const bf16x8*)(kb + (size_t)(j + 8) * 2048 + ks * 512);
            }
            const int key = 32 * j + l31;
#pragma unroll
            for (int rt = 0; rt < 4; ++rt) {
                float sv = 0.f;
#pragma unroll
                for (int q = 0; q < 16; ++q) sv += wv[rt][q] * fmaxf(acc[rt][q], 0.f);
                const int qi = 2 * rt + hh;
                const unsigned bits = __float_as_uint(sv);
                const unsigned uu = bits ^ ((bits >> 31) ? 0xffffffffu : 0x80000000u);
                SU[qi * 4096 + key] = (key <= t0 + qi) ? uu : 0u;
            }
        }
    }
    __syncthreads();
    {
        const int t = t0 + w, njw = (t >> 6) + 1, q = b * SL + t;
        const unsigned* row = SU + w * 4096;
        unsigned u[64];
#pragma unroll
        for (int jb = 0; jb < 8; ++jb) {
            if (jb * 8 < njw) {
#pragma unroll
                for (int jj = 0; jj < 8; ++jj) { const int j = jb * 8 + jj, key = 64 * j + lane; u[j] = (key <= t) ? row[key] : 0u; }
            } else {
#pragma unroll
                for (int jj = 0; jj < 8; ++jj) u[jb * 8 + jj] = 0;
            }
        }
        unsigned T = 1u; bool exact = true; int need = 0;
        if (t >= 256) {
            unsigned* hist = SU + w * 4096;
#pragma unroll
            for (int i = 0; i < 16; ++i) *(u32x4*)(hist + 4 * (lane + 64 * i)) = (u32x4){0u, 0u, 0u, 0u};
            asm volatile("" ::: "memory");
#pragma unroll
            for (int jb = 0; jb < 8; ++jb) if (jb * 8 < njw) {
#pragma unroll
                for (int jj = 0; jj < 8; ++jj) { const unsigned v = u[jb * 8 + jj];
                    __hip_atomic_fetch_add(hist + (v ? (v >> 20) : (unsigned)lane), 1u, __ATOMIC_RELAXED, __HIP_MEMORY_SCOPE_WORKGROUP); } }
            asm volatile("" ::: "memory");
            int sl = 0;
#pragma unroll
            for (int i = 0; i < 16; ++i) { const u32x4 h4 = *(const u32x4*)(hist + 64 * lane + 4 * i); sl += (int)(h4.x + h4.y + h4.z + h4.w); }
            int suf = sl;
#pragma unroll
            for (int o = 1; o < 64; o <<= 1) { const int v = __shfl_down(suf, o); if (lane + o < 64) suf += v; }
            const unsigned long long okm = __ballot(suf >= 256);
            const int Lh = 63 - __clzll(okm);
            const int sufL = __shfl(suf, Lh), slL = __shfl(sl, Lh);
            const int above = sufL - slL;
            int hs = (int)hist[64 * Lh + lane];
#pragma unroll
            for (int o = 1; o < 64; o <<= 1) { const int v = __shfl_down(hs, o); if (lane + o < 64) hs += v; }
            const unsigned long long okb = __ballot(hs + above >= 256);
            const int Ib = 63 - __clzll(okb);
            T = (unsigned)(64 * Lh + Ib) << 20; exact = false;
            for (int bit = 19; bit >= 0; --bit) {
                const unsigned cand = T | (1u << bit); int cl = 0;
#pragma unroll
                for (int jb = 0; jb < 8; ++jb) if (jb * 8 < njw) {
#pragma unroll
                    for (int jj = 0; jj < 8; ++jj) cl += (u[jb * 8 + jj] >= cand) ? 1 : 0; }
                int cnt = 0;
#pragma unroll
                for (int bb = 0; bb < 7; ++bb) cnt += __popcll(__ballot((cl >> bb) & 1)) << bb;
                if (cnt >= 256) { T = cand; if (cnt == 256) { exact = true; break; } }
            }
            if (!exact) { int cgt = 0;
#pragma unroll
                for (int j = 0; j < 64; ++j) cgt += __popcll(__ballot(u[j] > T));
                need = 256 - cgt; }
        }
        unsigned long long myw = 0;
        if (exact) {
#pragma unroll
            for (int j = 0; j < 64; ++j) { const unsigned long long m = __ballot(u[j] >= T); if (lane == j) myw = m; }
        } else {
#pragma unroll
            for (int j = 0; j < 64; ++j) {
                const unsigned long long gt = __ballot(u[j] > T); unsigned long long eq = __ballot(u[j] == T);
                while (__popcll(eq) > need) eq &= ~(1ull << (63 - __clzll(eq)));
                need -= __popcll(eq);
                const unsigned long long m = gt | eq; if (lane == j) myw = m; }
        }
        MK[(size_t)q * 64 + lane] = myw;
    }
    __syncthreads();
}

__device__ __forceinline__ void sgu_item(const Params& p, int layer, int item, unsigned char* smem) {
    const bf16_t* P = (const bf16_t*)(p.ws + WS_P); bf16_t* YA = (bf16_t*)(p.ws + WS_YA);
    const bf16_t* aws = (const bf16_t*)(p.ws + WS_AWS + SZ_AWS1 * layer);
    const int tid = otid(), lane = tid & 63, w = tid >> 6, hh = lane >> 5, l31 = lane & 31;
    const int b = item >> 8, n = (item >> 3) & 31, g = item & 7, tok0 = b * SL + n * 128;
#pragma unroll
    for (int i = 0; i < 4; ++i) { const int ch = tid + 512 * i, c8 = ch >> 7, s = ch & 127;
        const u32x4 v = *(const u32x4*)(P + pidx(tok0 + s, AV + g * 128 + c8 * 8));
        unsigned char* d = smem + (c8 * 8) * 272 + s * 2;
        *(bf16_t*)(d + 0 * 272) = (bf16_t)(v.x & 0xffff); *(bf16_t*)(d + 1 * 272) = (bf16_t)(v.x >> 16);
        *(bf16_t*)(d + 2 * 272) = (bf16_t)(v.y & 0xffff); *(bf16_t*)(d + 3 * 272) = (bf16_t)(v.y >> 16);
        *(bf16_t*)(d + 4 * 272) = (bf16_t)(v.z & 0xffff); *(bf16_t*)(d + 5 * 272) = (bf16_t)(v.z >> 16);
        *(bf16_t*)(d + 6 * 272) = (bf16_t)(v.w & 0xffff); *(bf16_t*)(d + 7 * 272) = (bf16_t)(v.w >> 16); }
    __syncthreads();
    const int tt = w & 3, cp = w >> 2, t = 32 * tt + l31, tok = tok0 + t;
    const float bias = p.a_b[(size_t)(layer * 8 + g) * 128 + t];
    const bf16_t* wsrow = aws + ((size_t)g * 128 + t) * 128 + hh * 8;
#pragma unroll
    for (int ci = 0; ci < 2; ++ci) {
        const int ct = cp * 2 + ci;
        f32x16 acc = {};
        for (int ks = 0; ks < 2 * (tt + 1); ++ks) {
            const bf16x8 A = *(const bf16x8*)(smem + (32 * ct + l31) * 272 + (ks * 16 + hh * 8) * 2);
            const bf16x8 Bv = *(const bf16x8*)(wsrow + ks * 16);
            acc = __builtin_amdgcn_mfma_f32_32x32x16_bf16(A, Bv, acc, 0, 0, 0);
        }
#pragma unroll
        for (int q4 = 0; q4 < 4; ++q4) {
            const int c = g * 128 + 32 * ct + 8 * q4 + 4 * hh;
            const u32x2 u4 = *(const u32x2*)(P + pidx(tok, AU + c)), z4 = *(const u32x2*)(P + pidx(tok, AZ + c));
            const float y0 = bf_lo(u4.x) * (acc[4 * q4 + 0] + bias) * siluf_(bf_lo(z4.x));
            const float y1 = bf_hi(u4.x) * (acc[4 * q4 + 1] + bias) * siluf_(bf_hi(z4.x));
            const float y2 = bf_lo(u4.y) * (acc[4 * q4 + 2] + bias) * siluf_(bf_lo(z4.y));
            const float y3 = bf_hi(u4.y) * (acc[4 * q4 + 3] + bias) * siluf_(bf_hi(z4.y));
            u32x2 o; o.x = cvt_pk_bf16(y0, y1); o.y = cvt_pk_bf16(y2, y3);
            *(u32x2*)(YA + oidx(tok, c, 1024, false)) = o;
        }
    }
    __syncthreads();
}

__device__ __forceinline__ void vt_item(const Params& p, int item, unsigned char* smem) {
    const bf16_t* P = (const bf16_t*)(p.ws + WS_P); bf16_t* VT = (bf16_t*)(p.ws + WS_VT);
    const int tid = otid();
    const int b = item >> 9, h = (item >> 6) & 7, st = item & 63;
#pragma unroll
    for (int i = 0; i < 2; ++i) { const int ch = tid + 512 * i, d8 = ch >> 6, s = ch & 63;
        const u32x4 v = *(const u32x4*)(P + pidx(b * SL + st * 64 + s, CV + h * 128 + d8 * 8));
        unsigned char* d = smem + (d8 * 8) * 144 + s * 2;
        *(bf16_t*)(d + 0 * 144) = (bf16_t)(v.x & 0xffff); *(bf16_t*)(d + 1 * 144) = (bf16_t)(v.x >> 16);
        *(bf16_t*)(d + 2 * 144) = (bf16_t)(v.y & 0xffff); *(bf16_t*)(d + 3 * 144) = (bf16_t)(v.y >> 16);
        *(bf16_t*)(d + 4 * 144) = (bf16_t)(v.z & 0xffff); *(bf16_t*)(d + 5 * 144) = (bf16_t)(v.z >> 16);
        *(bf16_t*)(d + 6 * 144) = (bf16_t)(v.w & 0xffff); *(bf16_t*)(d + 7 * 144) = (bf16_t)(v.w >> 16); }
    __syncthreads();
#pragma unroll
    for (int i = 0; i < 2; ++i) { const int ch = tid + 512 * i, d = ch >> 3, c16 = ch & 7;
        const u32x4 v = *(const u32x4*)(smem + d * 144 + c16 * 16);
        *(u32x4*)(VT + ((size_t)((b * 8 + h) * 128 + d)) * SL + st * 64 + c16 * 8) = v; }
    __syncthreads();
}

__device__ __forceinline__ void conv_item(const Params& p, int layer, int item) {
    const bf16_t* P = (const bf16_t*)(p.ws + WS_P); bf16_t* YB = (bf16_t*)(p.ws + WS_YB);
    const float* cw = p.b_conv + (size_t)layer * 3 * 1024;
    const int tid = otid();
#pragma unroll
    for (int i = 0; i < 4; ++i) {
        const int idx = tid + 512 * i, tk = idx >> 7, c = (idx & 127) * 8, tok = item * 16 + tk, tpos = tok & (SL - 1);
        const u32x4 bg = *(const u32x4*)(P + pidx(tok, BB + c)), zz = *(const u32x4*)(P + pidx(tok, BZ + c));
        const u32x4 c0 = *(const u32x4*)(P + pidx(tok, BC + c)), x0 = *(const u32x4*)(P + pidx(tok, BX + c));
        u32x4 c1 = (u32x4){0, 0, 0, 0}, x1 = c1, c2 = c1, x2 = c1;
        if (tpos >= 1) { c1 = *(const u32x4*)(P + pidx(tok - 1, BC + c)); x1 = *(const u32x4*)(P + pidx(tok - 1, BX + c)); }
        if (tpos >= 2) { c2 = *(const u32x4*)(P + pidx(tok - 2, BC + c)); x2 = *(const u32x4*)(P + pidx(tok - 2, BX + c)); }
        float y[8];
#pragma unroll
        for (int e = 0; e < 8; ++e) {
            const int wi = e >> 1; const bool hi = e & 1;
            const unsigned bgw = bg[wi], zw = zz[wi], c0w = c0[wi], x0w = x0[wi], c1w = c1[wi], x1w = x1[wi], c2w = c2[wi], x2w = x2[wi];
            const float fb = hi ? bf_hi(bgw) : bf_lo(bgw), fz = hi ? bf_hi(zw) : bf_lo(zw);
            const float a0 = (hi ? bf_hi(c0w) : bf_lo(c0w)) * (hi ? bf_hi(x0w) : bf_lo(x0w));
            const float a1 = (hi ? bf_hi(c1w) : bf_lo(c1w)) * (hi ? bf_hi(x1w) : bf_lo(x1w));
            const float a2 = (hi ? bf_hi(c2w) : bf_lo(c2w)) * (hi ? bf_hi(x2w) : bf_lo(x2w));
            const float cv = cw[2048 + c + e] * a0 + cw[1024 + c + e] * a1 + cw[c + e] * a2;
            y[e] = fb * cv * siluf_(fz);
        }
        u32x4 o; o.x = cvt_pk_bf16(y[0], y[1]); o.y = cvt_pk_bf16(y[2], y[3]); o.z = cvt_pk_bf16(y[4], y[5]); o.w = cvt_pk_bf16(y[6], y[7]);
        *(u32x4*)(YB + oidx(tok, c, 1024, false)) = o;
    }
}

__device__ __forceinline__ void phase_mixprep(const Params& p, int layer, unsigned char* smem) {
    constexpr int nI = 2048, nA = 1024, nV = 2048, nC = 1024;
    for (int j = blockIdx.x; j < nI + nA + nV + nC; j += gridDim.x) {
        if (j < nI) { for (int d = 0; d < 1 + ((PROBE_MIX >> 0) & 1); ++d) isel_item(p, j, smem); }
        else if (j < nI + nA) { for (int d = 0; d < 1 + ((PROBE_MIX >> 1) & 1); ++d) sgu_item(p, layer, j - nI, smem); }
        else if (j < nI + nA + nV) { for (int d = 0; d < 1 + ((PROBE_MIX >> 2) & 1); ++d) vt_item(p, j - nI - nA, smem); }
        else { for (int d = 0; d < 1 + ((PROBE_MIX >> 3) & 1); ++d) conv_item(p, layer, j - nI - nA - nV); }
    }
}

__device__ __forceinline__ int swap23(int i) { return (i & ~12) | ((i & 4) << 1) | ((i & 8) >> 1); }

__device__ __forceinline__ void phase_attn(const Params& p, unsigned char* smem) {
    const bf16_t* P = (const bf16_t*)(p.ws + WS_P); const bf16_t* VT = (const bf16_t*)(p.ws + WS_VT); bf16_t* YC = (bf16_t*)(p.ws + WS_YC);
    const unsigned long long* MK = (const unsigned long long*)(p.ws + WS_MASK);
    const int tid = otid(), lane = tid & 63, w = __builtin_amdgcn_readfirstlane(tid >> 6), hh = lane >> 5, l31 = lane & 31;
    constexpr int STG = 32768, KOFF = 0, VOFF = 16384;
    LAS unsigned char* lds = (LAS unsigned char*)smem;
    float* biasL = (float*)(smem + 3 * STG);
    constexpr float LOG2E = 1.4426950408889634f;
    const float sc = 0.08838834764831845f * LOG2E;
    int kro[2], vro[4];
#pragma unroll
    for (int c2 = 0; c2 < 2; ++c2) kro[c2] = (32 * c2 + swap23(l31)) * 256;
    const int krx = swap23(l31) & 15;
    const int vrx = (l31 >> 1) & 7;
#define ATT_WAIT_V(n) asm volatile("s_waitcnt vmcnt(" #n ")" ::: "memory")
#define ATT_ISSUE(kt_, stg_) do { const char* vg_ = (const char*)Vg + (size_t)(kt_) * 128; \
        int li_ = lane; asm volatile("" : "+v"(li_)); \
        _Pragma("unroll") for (int i_ = 0; i_ < 2; ++i_) { const int n_ = w + 8 * i_; \
            const int kr_ = 4 * n_ + (li_ >> 4), kc_ = (li_ & 15) ^ (kr_ & 15); const char* kga_ = (const char*)(P + pidx(b * SL + (kt_) * 64 + kr_, CK + h * 128 + kc_ * 8)); \
            const int vd_ = 8 * n_ + (li_ >> 3), vc_ = (li_ & 7) ^ ((vd_ >> 1) & 7); const unsigned vgo_ = (unsigned)(vd_ * SL * 2 + vc_ * 16); \
            __builtin_amdgcn_global_load_lds((const unsigned*)(kga_), (LAS unsigned*)(lds + (stg_) * STG + KOFF + n_ * 1024), 16, 0, 0); \
            __builtin_amdgcn_global_load_lds((const unsigned*)(vg_ + vgo_), (LAS unsigned*)(lds + (stg_) * STG + VOFF + n_ * 1024), 16, 0, 0); } } while (0)
    for (int item = blockIdx.x; item < 256; item += gridDim.x) {
        const int bh = (item & 7) + 8 * (item >> 6), pr = (item >> 3) & 7, b = bh >> 3, h = bh & 7;
        __syncthreads();
        if (tid < 129) { int bk = tid; if (tid >= 16) { bk = 16 + (int)(logf((float)tid * 0.0625f) / 2.0794415416798357f * 16.0f); bk = bk > 31 ? 31 : bk; } if (tid >= 128) bk = 31;
            biasL[tid] = (p.rel_bias[bk * 8 + h] - p.rel_bias[31 * 8 + h]) * LOG2E; }
        __syncthreads();
        const bf16_t* Vg = VT + (size_t)((b * 8 + h) * 128) * SL;
        for (int si = 0; si < 2; ++si) {
            const int qt = si ? pr : 15 - pr, q0 = qt * 256, tq = q0 + 32 * w + l31, tokq = b * SL + tq;
            const int nkt = (q0 + 256) >> 6, wlast = (q0 + 32 * w + 31) >> 6;
            bf16x8 Qf[8];
#pragma unroll
            for (int ks = 0; ks < 8; ++ks) { const u32x4 q4 = *(const u32x4*)(P + pidx(tokq, CQ + h * 128 + ks * 16 + hh * 8));
                u32x4 qs; qs.x = cvt_pk_bf16(bf_lo(q4.x) * sc, bf_hi(q4.x) * sc); qs.y = cvt_pk_bf16(bf_lo(q4.y) * sc, bf_hi(q4.y) * sc);
                qs.z = cvt_pk_bf16(bf_lo(q4.z) * sc, bf_hi(q4.z) * sc); qs.w = cvt_pk_bf16(bf_lo(q4.w) * sc, bf_hi(q4.w) * sc);
                __builtin_memcpy(&Qf[ks], &qs, 16); }
            const unsigned long long* mrow = MK + (size_t)tokq * 64;
            unsigned long long mnext = mrow[0];
            ATT_WAIT_V(0);
            ATT_ISSUE(0, 0);
            ATT_ISSUE(1, 1);
            f32x16 O[4];
#pragma unroll
            for (int dt = 0; dt < 4; ++dt) O[dt] = (f32x16){};
            float mrun = -1e30f, lsum = 0.f;
            int stg = 0;
            for (int kt = 0; kt < nkt; ++kt) {
                ATT_WAIT_V(4);
                __builtin_amdgcn_s_barrier();
                const unsigned long long mw = mnext;
                if (kt + 1 <= wlast) mnext = mrow[kt + 1];
                { const int k2 = (kt + 2 < nkt) ? kt + 2 : nkt - 1; const int s2 = (stg + 2 >= 3) ? stg - 1 : stg + 2; ATT_ISSUE(k2, s2); }
                if (kt <= wlast) {
                    LAS const unsigned char* Kc = lds + stg * STG + KOFF; LAS const unsigned char* Vc = lds + stg * STG + VOFF;
                    f32x16 sa[2];
#pragma unroll
                    for (int c2 = 0; c2 < 2; ++c2) {
                        sa[c2] = (f32x16){};
#pragma unroll
                        for (int ks = 0; ks < 8; ++ks) sa[c2] = __builtin_amdgcn_mfma_f32_32x32x16_bf16(*(LAS const bf16x8*)(Kc + kro[c2] + (((2 * ks + hh) ^ krx) << 4)), Qf[ks], sa[c2], 0, 0, 0);
                    }
                    const bool far = ((q0 + 32 * w) - (64 * kt + 63)) >= 128;
                    const int dist0 = tq - (64 * kt + 8 * hh);
                    const unsigned mlo = ((unsigned)mw) >> (8 * hh), mhi = ((unsigned)(mw >> 32)) >> (8 * hh);
                    if (!far) {
#pragma unroll
                        for (int c2 = 0; c2 < 2; ++c2)
#pragma unroll
                            for (int r = 0; r < 16; ++r) { int d = dist0 - (32 * c2 + 16 * (r >> 3) + (r & 7)); d = d < 0 ? 0 : (d > 128 ? 128 : d); sa[c2][r] += biasL[d]; }
                    }
                    float mx = fmaxf(sa[0][0], sa[1][0]);
#pragma unroll
                    for (int r = 1; r < 16; ++r) mx = fmaxf(fmaxf(mx, sa[0][r]), sa[1][r]);
                    mx = fmaxf(mx, __shfl_xor(mx, 32));
                    float alpha = 1.0f;
                    const bool grow = __ballot(mx > mrun + 8.0f) != 0ull;
                    if (grow) { const float mnew_ = fmaxf(mrun, mx); alpha = fast_exp2(mrun - mnew_); mrun = mnew_; }
                    const float mnew = mrun;
                    float ps = 0.f;
#pragma unroll
                    for (int c2 = 0; c2 < 2; ++c2)
#pragma unroll
                        for (int r = 0; r < 16; ++r) {
                            const int e = __builtin_amdgcn_sbfe((int)(c2 ? mhi : mlo), 16 * (r >> 3) + (r & 7), 1);
                            const float pv = __uint_as_float(__float_as_uint(fast_exp2(sa[c2][r] - mnew)) & (unsigned)e);
                            sa[c2][r] = pv; ps += pv; }
                    lsum = lsum * alpha + ps;
                    if (grow) {
#pragma unroll
                        for (int dt = 0; dt < 4; ++dt) O[dt] *= alpha;
                    }
#pragma unroll
                    for (int c2 = 0; c2 < 2; ++c2)
#pragma unroll
                        for (int c = 0; c < 2; ++c) {
                            u32x4 pw; pw.x = cvt_pk_bf16(sa[c2][8 * c + 0], sa[c2][8 * c + 1]); pw.y = cvt_pk_bf16(sa[c2][8 * c + 2], sa[c2][8 * c + 3]);
                            pw.z = cvt_pk_bf16(sa[c2][8 * c + 4], sa[c2][8 * c + 5]); pw.w = cvt_pk_bf16(sa[c2][8 * c + 6], sa[c2][8 * c + 7]);
                            bf16x8 Pf; __builtin_memcpy(&Pf, &pw, 16);
                            const int vch = ((4 * c2 + 2 * c + hh) ^ vrx) << 4;
#pragma unroll
                            for (int dt = 0; dt < 4; ++dt) O[dt] = __builtin_amdgcn_mfma_f32_32x32x16_bf16(*(LAS const bf16x8*)(Vc + (32 * dt + l31) * 128 + vch), Pf, O[dt], 0, 0, 0);
                        }
                }
                stg = (stg == 2) ? 0 : stg + 1;
            }
            ATT_WAIT_V(0);
            __builtin_amdgcn_s_barrier();
            lsum += __shfl_xor(lsum, 32);
            const float inv = 1.0f / lsum;
#pragma unroll
            for (int dt = 0; dt < 4; ++dt)
#pragma unroll
                for (int q4 = 0; q4 < 4; ++q4) {
                    const int d = h * 128 + 32 * dt + 8 * q4 + 4 * hh;
                    const u32x2 z4 = *(const u32x2*)(P + pidx(tokq, CZ + d));
                    const float y0 = O[dt][4 * q4 + 0] * inv * siluf_(bf_lo(z4.x)), y1 = O[dt][4 * q4 + 1] * inv * siluf_(bf_hi(z4.x));
                    const float y2 = O[dt][4 * q4 + 2] * inv * siluf_(bf_lo(z4.y)), y3 = O[dt][4 * q4 + 3] * inv * siluf_(bf_hi(z4.y));
                    u32x2 o; o.x = cvt_pk_bf16(y0, y1); o.y = cvt_pk_bf16(y2, y3);
                    *(u32x2*)(YC + oidx(tokq, d, 1024, false)) = o;
                }
        }
    }
#undef ATT_WAIT_V
#undef ATT_ISSUE
}

#define XB_TMO      128
#define XB_XCNT(j)  (256  + 64 * (j))
#define XB_XSUB(j)  (1280 + 64 * (j))
#define XB_XGEN(j)  (2304 + 64 * (j))
#define XB_TOP      3328
#define XB_TOPGEN   3392
#define XCD_BAR_WORDS 3456
#define XB_SPIN_CAP (1u << 18)
__device__ __forceinline__ unsigned xb_ld(unsigned* p)              { return __hip_atomic_load(p, __ATOMIC_RELAXED, __HIP_MEMORY_SCOPE_AGENT); }
__device__ __forceinline__ unsigned xb_add(unsigned* p, unsigned v) { return __hip_atomic_fetch_add(p, v, __ATOMIC_RELAXED, __HIP_MEMORY_SCOPE_AGENT); }
__device__ __forceinline__ unsigned xb_xcc_id() { return (unsigned)__builtin_amdgcn_s_getreg((3 << 11) | 20) & 0xFu; }
#define XB_SPIN(cond, bar) do { unsigned _sp = 0; while (cond) { __builtin_amdgcn_s_sleep(1); \
    if ((++_sp & 255u) == 0u) { if (xb_ld(&(bar)[XB_TMO])) break; if (_sp > XB_SPIN_CAP) { atomicAdd(&(bar)[XB_TMO], 1u); break; } } } } while (0)
struct XcdBarrier { unsigned* bar; unsigned x; volatile LAS unsigned* st; };
__device__ __forceinline__ XcdBarrier xcd_barrier_post(unsigned* bar, volatile LAS unsigned* st) {
    XcdBarrier b; b.bar = bar; b.x = xb_xcc_id(); b.st = st;
    if (__builtin_amdgcn_workitem_id_x() == 0) (void)xb_add(&bar[XB_XCNT(b.x)], 1u);
    return b;
}
__device__ __forceinline__ void xcd_barrier_complete(unsigned* bar, unsigned x, unsigned& nloc, unsigned& nx) {
    const unsigned G = gridDim.x;
    unsigned sum, cnt, mine, sp = 0u;
    for (;;) {
        sum = 0u; cnt = 0u; mine = 0u;
#pragma unroll
        for (unsigned j = 0; j < 16; ++j) { const unsigned c = xb_ld(&bar[XB_XCNT(j)]); sum += c; cnt += (c > 0u) ? 1u : 0u; mine = (j == x) ? c : mine; }
        if (sum == G) break;
        __builtin_amdgcn_s_sleep(1);
        if ((++sp & 255u) == 0u) { if (xb_ld(&bar[XB_TMO])) break; if (sp > XB_SPIN_CAP) { atomicAdd(&bar[XB_TMO], 1u); break; } }
    }
    nloc = mine > 0u ? mine : 1u; nx = cnt > 0u ? cnt : 1u;
}
__device__ __forceinline__ void xcd_barrier(const XcdBarrier& b) {
    asm volatile("s_waitcnt vmcnt(0)" ::: "memory");
    __syncthreads();
    if (__builtin_amdgcn_workitem_id_x() == 0) {
        unsigned* bar = b.bar;
        __builtin_amdgcn_s_waitcnt(0);
        unsigned nloc = b.st[0], nx = b.st[1];
        if (nloc == 0u) { xcd_barrier_complete(bar, b.x, nloc, nx); b.st[0] = nloc; b.st[1] = nx; }
        const unsigned old = xb_add(&bar[XB_XSUB(b.x)], 1u);
        const unsigned gen = old / nloc;
        if (old + 1u == (gen + 1u) * nloc) {
            __builtin_amdgcn_fence(__ATOMIC_RELEASE, "agent");
            asm volatile("s_waitcnt vmcnt(0)" ::: "memory");
            const unsigned og = xb_add(&bar[XB_TOP], 1u);
            const unsigned tg = og / nx;
            if (og + 1u == (tg + 1u) * nx) xb_add(&bar[XB_TOPGEN], 1u);
            else XB_SPIN(xb_ld(&bar[XB_TOPGEN]) == tg, bar);
            __builtin_amdgcn_fence(__ATOMIC_ACQUIRE, "agent");
            xb_add(&bar[XB_XGEN(b.x)], 1u);
            asm volatile("s_waitcnt vmcnt(0)" ::: "memory");
        } else {
            XB_SPIN(xb_ld(&bar[XB_XGEN(b.x)]) == gen, bar);
            __builtin_amdgcn_fence(__ATOMIC_ACQUIRE, "agent");
            asm volatile("s_waitcnt vmcnt(0)" ::: "memory");
        }
    }
    __syncthreads();
}

__device__ __forceinline__ void gemm_call(const Params& p, int layer, int sub, int rep, unsigned char* smem) {
    LAS unsigned char* lds = (LAS unsigned char*)smem;
    bf16_t* H = (bf16_t*)(p.ws + WS_H); bf16_t* P = (bf16_t*)(p.ws + WS_P); float* X = (float*)(p.ws + WS_X);
    pg8::Gemm g; EpiAll E; pg8::StaticOrder S;
    E.O = P; E.ldc = NP; E.IKF = (bf16_t*)(p.ws + WS_IKF); E.sig_from = GA / 128; E.T = (float*)(p.ws + WS_T); E.Mout = (bf16_t*)(p.ws + WS_MM); E.Xin = (layer == 0) ? p.x : X; E.Xout = X; E.gcol0 = GA + rep * DM;
    g.M = MT;
    if (sub == 0) { g.A = H; g.Bt = (const bf16_t*)(p.ws + WS_WTIN + SZ_WTIN1 * layer); g.N = NP; g.K = DM; E.mode = 0; }
    else if (sub == 4) { g.A = (const bf16_t*)(p.ws + WS_YA + (size_t)rep * MT * 1024 * 2); g.Bt = (const bf16_t*)(p.ws + WS_WTPA + SZ_WTP1 * DEPTH * rep + SZ_WTP1 * layer); g.N = DM; g.K = 1024; E.mode = 1 + rep; }
    else { g.A = (const bf16_t*)(p.ws + WS_MM); g.Bt = (const bf16_t*)(p.ws + WS_WTO + SZ_WTO1 * layer); g.N = DM; g.K = DM; E.mode = 4; }
    S.init(MT, g.N, gridDim.x, blockIdx.x);
    pg8::gemm_phase(lds, g, S, E);
    __syncthreads();
}

#if MULTI_LAUNCH
__global__ void __launch_bounds__(512, 2) k_prep(Params p) { extern __shared__ __attribute__((aligned(16))) unsigned char smem[]; phase_prep(p, smem); }
__global__ void __launch_bounds__(512, 2) k_gemm(Params p, int layer, int sub, int rep) { extern __shared__ __attribute__((aligned(16))) unsigned char smem[]; gemm_call(p, layer, sub, rep, smem); }
__global__ void __launch_bounds__(512, 2) k_mix(Params p, int layer) { extern __shared__ __attribute__((aligned(16))) unsigned char smem[]; phase_mixprep(p, layer, smem); }
__global__ void __launch_bounds__(512, 2) k_attn(Params p) { extern __shared__ __attribute__((aligned(16))) unsigned char smem[]; phase_attn(p, smem); }
__global__ void __launch_bounds__(512, 2) k_norm(Params p, int layer) {
    float* X = (float*)(p.ws + WS_X);
    if (layer + 1 < DEPTH) rmsnorm_rows(X, p.norm_g + (size_t)(layer + 1) * DM, (bf16_t*)(p.ws + WS_H), nullptr);
    else rmsnorm_rows(X, p.final_g, nullptr, p.out);
}
#else
__global__ void __launch_bounds__(512, 2) fwd_megakernel(Params p) {
    extern __shared__ __attribute__((aligned(16))) unsigned char smem[];
    cg::grid_group grid = cg::this_grid();
    const int lo = p.ph_lo, hi = p.ph_hi;
    volatile LAS unsigned* xbst = (volatile LAS unsigned*)((LAS unsigned char*)smem + 131072);
    if (__builtin_amdgcn_workitem_id_x() == 0) { xbst[0] = 0u; xbst[1] = 0u; }
    __syncthreads();
    const XcdBarrier xbar = xcd_barrier_post((unsigned*)(p.ws + WS_BAR), xbst);
#define IN(k) (lo <= (k) && (k) < hi)
#define SEAM(k) do { if (IN(k) && IN((k) + 1)) { if ((k) == 0) grid.sync(); else xcd_barrier(xbar); } } while (0)
    for (int dup = 0; dup < 1 + ((PROBE_DUP >> 5) & 1); ++dup) { if (IN(0)) { phase_prep(p, smem); }
    SEAM(0); }
    for (int layer = 0; layer < DEPTH; ++layer) {
        const int b = 1 + 7 * layer;
        for (int dup = 0; dup < 1 + ((PROBE_DUP >> 0) & 1); ++dup) { if (IN(b + 0)) {
            gemm_call(p, layer, 0, 0, smem);
            const int nun = (MT / 256) * (NP / 256), rem = nun % (int)gridDim.x, idle = (int)gridDim.x - rem;
            if (layer + 1 < DEPTH && dup == 0) {
                if (rem == 0) convert_layer(p, (float*)smem, layer + 1, blockIdx.x, gridDim.x);
                else if ((int)blockIdx.x >= rem) convert_layer(p, (float*)smem, layer + 1, (int)blockIdx.x - rem, idle);
            } }
        SEAM(b + 0); }
        for (int dup = 0; dup < 1 + ((PROBE_DUP >> 1) & 1); ++dup) { if (IN(b + 1)) phase_mixprep(p, layer, smem);
        SEAM(b + 1); }
        for (int dup = 0; dup < 1 + ((PROBE_DUP >> 3) & 1); ++dup) { if (IN(b + 3)) phase_attn(p, smem);
        SEAM(b + 3); }
        for (int dup = 0; dup < 1 + ((PROBE_DUP >> 4) & 1); ++dup) { if (IN(b + 4)) { for (int rep = 0; rep < 3; ++rep) gemm_call(p, layer, 4, rep, smem); }
        SEAM(b + 4); }
        if (IN(b + 5)) gemm_call(p, layer, 5, 0, smem);
        SEAM(b + 5);
        if (IN(b + 6)) {
            float* X = (float*)(p.ws + WS_X);
            if (layer + 1 < DEPTH) rmsnorm_rows(X, p.norm_g + (size_t)(layer + 1) * DM, (bf16_t*)(p.ws + WS_H), nullptr);
            else rmsnorm_rows(X, p.final_g, nullptr, p.out);
        }
        SEAM(b + 6);
    }
#undef IN
#undef SEAM
}

#endif

extern "C" void kernel_launch(void* const* d_in, const int* in_sizes, int n_in, void* d_out, int out_size, void* d_ws, size_t ws_size, hipStream_t stream) {
    static int grid_blocks = 0;
    if (!grid_blocks) {
        if (n_in != 12 || out_size != MT * DM || ws_size < WS_END) { fprintf(stderr, "kernel_launch: unexpected shapes (n_in %d out %d ws %zu need %zu)\n", n_in, out_size, ws_size, (size_t)WS_END); grid_blocks = -1; return; }
        int dev = 0, cus = 0;
        (void)hipGetDevice(&dev);
        (void)hipDeviceGetAttribute(&cus, hipDeviceAttributeMultiprocessorCount, dev);
        bool ok = true;
#if MULTI_LAUNCH
        ok = ok && hipFuncSetAttribute((const void*)k_prep, hipFuncAttributeMaxDynamicSharedMemorySize, LDS_BYTES) == hipSuccess;
        ok = ok && hipFuncSetAttribute((const void*)k_gemm, hipFuncAttributeMaxDynamicSharedMemorySize, LDS_BYTES) == hipSuccess;
        ok = ok && hipFuncSetAttribute((const void*)k_mix, hipFuncAttributeMaxDynamicSharedMemorySize, LDS_BYTES) == hipSuccess;
        ok = ok && hipFuncSetAttribute((const void*)k_attn, hipFuncAttributeMaxDynamicSharedMemorySize, LDS_BYTES) == hipSuccess;
#else
        ok = ok && hipFuncSetAttribute((const void*)fwd_megakernel, hipFuncAttributeMaxDynamicSharedMemorySize, LDS_BYTES) == hipSuccess;
        int per_cu = 0;
        (void)hipOccupancyMaxActiveBlocksPerMultiprocessor(&per_cu, (const void*)fwd_megakernel, 512, LDS_BYTES);
        if (per_cu < 1) fprintf(stderr, "kernel_launch: occupancy query says %d blocks per CU\n", per_cu);
#endif
        if (!ok) { fprintf(stderr, "kernel_launch: hipFuncSetAttribute failed\n"); grid_blocks = -1; return; }
        grid_blocks = cus > 0 ? cus : 256;
    }
    if (grid_blocks < 0) return;
    Params p{};
    p.x = (const float*)d_in[0]; p.norm_g = (const float*)d_in[1]; p.w_in = (const float*)d_in[2]; p.a_ws = (const float*)d_in[3]; p.a_b = (const float*)d_in[4];
    p.b_conv = (const float*)d_in[5]; p.p_a = (const float*)d_in[6]; p.p_b = (const float*)d_in[7]; p.p_c = (const float*)d_in[8]; p.w_o = (const float*)d_in[9];
    p.rel_bias = (const float*)d_in[10]; p.final_g = (const float*)d_in[11];
    p.out = (float*)d_out; p.ws = (unsigned char*)d_ws;
#if MULTI_LAUNCH
    const dim3 G(grid_blocks), B(512);
    hipLaunchKernelGGL(k_prep, G, B, LDS_BYTES, stream, p);
    for (int layer = 0; layer < DEPTH; ++layer) {
        hipLaunchKernelGGL(k_gemm, G, B, LDS_BYTES, stream, p, layer, 0, 0);
        hipLaunchKernelGGL(k_mix, G, B, LDS_BYTES, stream, p, layer);
        hipLaunchKernelGGL(k_attn, G, B, LDS_BYTES, stream, p);
        for (int rep = 0; rep < 3; ++rep) hipLaunchKernelGGL(k_gemm, G, B, LDS_BYTES, stream, p, layer, 4, rep);
        hipLaunchKernelGGL(k_gemm, G, B, LDS_BYTES, stream, p, layer, 5, 0);
        hipLaunchKernelGGL(k_norm, G, B, 0, stream, p, layer);
    }
#else
    p.ph_lo = 0; p.ph_hi = NPHASES;
    (void)hipMemsetAsync((unsigned char*)d_ws + WS_BAR, 0, 16384, stream);
    void* args[] = {&p};
    hipError_t e = hipLaunchCooperativeKernel((const void*)fwd_megakernel, dim3(grid_blocks), dim3(512), args, LDS_BYTES, stream);
    if (e != hipSuccess) fprintf(stderr, "cooperative launch failed: %s (grid %d)\n", hipGetErrorString(e), grid_blocks);
#endif
}
```

```cpp
#include <hip/hip_runtime.h>
#include <hip/hip_cooperative_groups.h>
#include <cstdio>
#include <cmath>
namespace cg = cooperative_groups;

#ifndef MULTI_LAUNCH
#define MULTI_LAUNCH 0
#endif

#ifndef PROBE_MIX
#define PROBE_MIX 0
#endif
#ifndef PROBE_DUP
#define PROBE_DUP 0
#endif
#define LAS __attribute__((address_space(3)))
typedef unsigned short bf16_t;
typedef short bf16x8 __attribute__((ext_vector_type(8)));
typedef float f32x4 __attribute__((ext_vector_type(4)));
typedef float f32x16 __attribute__((ext_vector_type(16)));
typedef unsigned u32x4 __attribute__((ext_vector_type(4)));
typedef unsigned u32x2 __attribute__((ext_vector_type(2)));

constexpr int DM = 2048, NB = 4, SL = 4096, DEPTH = 4, MT = NB * SL;
constexpr int INC = 18512;
constexpr int NP = 18688;
constexpr int AU = 0, AV = 1024, AZ = 2048, BB = 3072, BC = 4096, BX = 5120, BZ = 6144, CQ = 7168, CK = 8192, CV = 9216, CZ = 10240,
              IQ = 11264, IK = 12288, IW = 12352, GA = 12416, GB = 14464, GC = 16512;
constexpr int NPHASES = 1 + 7 * DEPTH;

constexpr size_t WS_WTIN = 0;
constexpr size_t SZ_WTIN1 = (size_t)NP * DM * 2;
constexpr size_t WS_WTPA = WS_WTIN + SZ_WTIN1 * DEPTH;
constexpr size_t SZ_WTP1 = (size_t)DM * 1024 * 2;
constexpr size_t WS_WTPB = WS_WTPA + SZ_WTP1 * DEPTH;
constexpr size_t WS_WTPC = WS_WTPB + SZ_WTP1 * DEPTH;
constexpr size_t WS_WTO = WS_WTPC + SZ_WTP1 * DEPTH;
constexpr size_t SZ_WTO1 = (size_t)DM * DM * 2;
constexpr size_t WS_AWS = WS_WTO + SZ_WTO1 * DEPTH;
constexpr size_t SZ_AWS1 = (size_t)8 * 128 * 128 * 2;
constexpr size_t WS_H = WS_AWS + SZ_AWS1 * DEPTH;
constexpr size_t WS_P = WS_H + (size_t)MT * DM * 2;
constexpr size_t WS_X = WS_P + (size_t)MT * NP * 2;
constexpr size_t WS_YA = WS_X + (size_t)MT * DM * 4;
constexpr size_t WS_YB = WS_YA + (size_t)MT * 1024 * 2;
constexpr size_t WS_YC = WS_YB + (size_t)MT * 1024 * 2;
constexpr size_t WS_T = WS_YC + (size_t)MT * 1024 * 2;
constexpr size_t WS_MM = WS_T + (size_t)MT * DM * 4;
constexpr size_t WS_S = WS_MM + (size_t)MT * DM * 2;
constexpr size_t WS_MASK = WS_S + (size_t)MT * SL * 4;
constexpr size_t WS_VT = WS_MASK + (size_t)MT * 64 * 8;
constexpr size_t WS_BAR = WS_VT + (size_t)MT * 1024 * 2;
constexpr size_t WS_END = WS_BAR + 16384;

constexpr size_t WS_IKF = WS_S;
constexpr int LDS_BYTES = 131072 + 64;

struct Params {
    const float *x, *norm_g, *w_in, *a_ws, *a_b, *b_conv, *p_a, *p_b, *p_c, *w_o, *rel_bias, *final_g;
    float* out;
    unsigned char* ws;
    int ph_lo, ph_hi;
};

__device__ __forceinline__ size_t pidx(int tok, int col) {
    const int r = tok & 255, c = col & 255;
    return ((size_t)((tok >> 8) * (NP / 256) + (col >> 8)) << 16) + (size_t)(((((r >> 4) * 2 + (c >> 7)) * 4 + ((c >> 5) & 3)) << 9) + ((r & 15) << 5) + (c & 31));
}
__device__ __forceinline__ unsigned cvt_pk_bf16(float lo, float hi) { unsigned r; asm("v_cvt_pk_bf16_f32 %0, %1, %2" : "=v"(r) : "v"(lo), "v"(hi)); return r; }
__device__ __forceinline__ int otid() { int t = __builtin_amdgcn_workitem_id_x(); asm volatile("" : "+v"(t)); return t; }
__device__ __forceinline__ float bf_lo(unsigned w) { return __uint_as_float(w << 16); }
__device__ __forceinline__ float bf_hi(unsigned w) { return __uint_as_float(w & 0xffff0000u); }
__device__ __forceinline__ float bf2f(bf16_t b) { return __uint_as_float(((unsigned)b) << 16); }
__device__ __forceinline__ float fast_exp2(float x) { return __builtin_amdgcn_exp2f(x); }
__device__ __forceinline__ float sigmoidf_(float x) { return __builtin_amdgcn_rcpf(1.0f + __expf(-x)); }
__device__ __forceinline__ float siluf_(float x) { return x * sigmoidf_(x); }

namespace pg8 {
constexpr int BM = 256, BK = 64, HALF = 128, HTB = HALF * BK * 2, STAGE_BYTES = 8 * HTB, NXCD = 8, WGM = 8;
__host__ __device__ __forceinline__ int lds_byte(int r, int c) { const int st = (r >> 4) * 2 + (c >> 5), rr = r & 15, cc = c & 31, ob = rr * 64 + cc * 2; return st * 1024 + (ob ^ (((ob >> 9) & 1) << 5)); }
__host__ __device__ __forceinline__ void stage_rc(int b, int& R, int& C) { const int st = b / 1024, sb = b % 1024, swz = sb ^ (((sb >> 9) & 1) << 5); R = (st >> 1) * 16 + swz / 64; C = (st & 1) * 32 + (swz % 64) / 2; }
__host__ __device__ __forceinline__ int perm32(int rho) { const int n = rho >> 4, i = rho & 15; return 8 * (i >> 2) + 4 * n + (i & 3); }
struct Unit { int pm, pn; };
struct Gemm { const bf16_t* A; const bf16_t* Bt; int M, N, K; };
struct StaticOrder {
    int nM, nN, nwg, G, c;
    __host__ __device__ void init(int M, int N, int G_, int c_) { nM = M / BM; nN = N / BM; nwg = nM * nN; G = G_; c = c_; }
    __host__ __device__ bool next(int i, Unit& u) const {
        const int L = i * G + c; if (L >= nwg) return false;
        const int wgid = (L & 7) * (nwg >> 3) + (L >> 3);
        int gid, within;
        if (nN == 8) { gid = wgid >> 6; within = wgid & 63; } else { gid = wgid / 584; within = wgid - gid * 584; }
        u.pm = gid * 8 + (within & 7); u.pn = within >> 3; return true;
    }
};

template <class Epi>
__device__ __forceinline__ void gemm_phase(LAS unsigned char* lds, const Gemm g, const StaticOrder& S, const Epi& E) {
    const int tid = otid(), wid = __builtin_amdgcn_readfirstlane(tid >> 6), lane = tid & 63, wr = wid >> 2, wc = wid & 3, fr = lane & 15, fq = lane >> 4;
    const int K = g.K, nt = K / BK;
    unsigned voffA[2], voffB[2];
#pragma unroll
    for (int i = 0; i < 2; ++i) { int R, C; stage_rc(tid * 16 + i * 8192, R, C); const int Rb = (R & ~31) + perm32(R & 31);
        (void)R; (void)C; (void)Rb; voffA[i] = (unsigned)(tid * 16 + i * 8192); voffB[i] = voffA[i]; }
    const size_t kstep = (size_t)32768;
    const size_t hstep = (size_t)16384;
    const size_t tstep = (size_t)(K / BK) * kstep;
    const unsigned ldsw = (unsigned)wid * 1024u;
    const int aoff = lds_byte(wr * 64 + fr, fq * 8), boff = lds_byte(wc * 32 + fr, fq * 8);
#define PG8_SA(b, h) (((b) * 2 + (h)) * HTB)
#define PG8_SB(b, h) ((4 + (b) * 2 + (h)) * HTB)
#define PG8_STAGE(bufoff, gbase, voff) do { _Pragma("unroll") for (int _i = 0; _i < 2; ++_i) \
        __builtin_amdgcn_global_load_lds((const unsigned*)((const char*)(gbase) + (voff)[_i]), (LAS unsigned*)(lds + (bufoff) + ldsw + _i * 8192), 16, 0, 0); } while (0)
#define PG8_LDA(dst, b, h) do { _Pragma("unroll") for (int m = 0; m < 4; ++m) _Pragma("unroll") for (int k = 0; k < 2; ++k) dst[m][k] = *(const LAS bf16x8*)(lds + PG8_SA(b, h) + aoff + m * 2048 + k * 1024); } while (0)
#define PG8_LDB(dst, b, h) do { _Pragma("unroll") for (int n = 0; n < 2; ++n) _Pragma("unroll") for (int k = 0; k < 2; ++k) dst[n][k] = *(const LAS bf16x8*)(lds + PG8_SB(b, h) + boff + n * 2048 + k * 1024); } while (0)
#define PG8_MMA(ai, bj, At, Bt) do { __builtin_amdgcn_s_setprio(1); _Pragma("unroll") for (int m = 0; m < 4; ++m) _Pragma("unroll") for (int n = 0; n < 2; ++n) _Pragma("unroll") for (int k = 0; k < 2; ++k) \
        acc[ai][bj][m][n] = __builtin_amdgcn_mfma_f32_16x16x32_bf16(Bt[n][k], At[m][k], acc[ai][bj][m][n], 0, 0, 0); __builtin_amdgcn_s_setprio(0); } while (0)
#define PG8_WAIT_V(n) asm volatile("s_waitcnt vmcnt(" #n ")" ::: "memory")
#define PG8_WAIT_L(n) asm volatile("s_waitcnt lgkmcnt(" #n ")" ::: "memory")
#define PG8_BAR __builtin_amdgcn_s_barrier()
#define PG8_SCHED __builtin_amdgcn_sched_barrier(0)
    Unit cur, nxt; int ui = 0;
    if (!S.next(0, cur)) return;
    f32x4 acc[2][2][4][2];
#pragma unroll
    for (int a = 0; a < 2; ++a)
#pragma unroll
        for (int b = 0; b < 2; ++b)
#pragma unroll
            for (int m = 0; m < 4; ++m)
#pragma unroll
                for (int n = 0; n < 2; ++n) acc[a][b][m][n] = (f32x4){0.f, 0.f, 0.f, 0.f};
    bf16x8 At[4][2], B0[2][2], B1[2][2];
    const char* cA = (const char*)g.A + (size_t)cur.pm * tstep; const char* cB = (const char*)g.Bt + (size_t)cur.pn * tstep;
    PG8_STAGE(PG8_SB(0, 0), cB, voffB); PG8_STAGE(PG8_SB(0, 1), cB + hstep, voffB); PG8_STAGE(PG8_SA(0, 0), cA, voffA); PG8_STAGE(PG8_SA(0, 1), cA + hstep, voffA);
    if (wr == 1) PG8_BAR;
    PG8_WAIT_V(2); PG8_BAR;
    PG8_STAGE(PG8_SB(1, 0), cB + kstep, voffB); PG8_STAGE(PG8_SA(1, 0), cA + kstep, voffA); PG8_STAGE(PG8_SB(1, 1), cB + hstep + kstep, voffB);
    PG8_WAIT_V(6); PG8_BAR;
    for (;;) {
        const bool has_next = S.next(ui + 1, nxt);
        const char* nA = has_next ? (const char*)g.A + (size_t)nxt.pm * tstep : cA; const char* nB = has_next ? (const char*)g.Bt + (size_t)nxt.pn * tstep : cB;
        for (int t = 0; t < nt; t += 2) {
            const bool last = (t == nt - 2);
            const char* a1 = cA + (size_t)(t + 1) * kstep;
            const char* a2 = last ? nA : cA + (size_t)(t + 2) * kstep; const char* b2 = last ? nB : cB + (size_t)(t + 2) * kstep;
            const char* a3 = a2 + kstep; const char* b3 = b2 + kstep;
            PG8_LDB(B0, 0, 0); PG8_LDB(B1, 0, 1); PG8_SCHED; PG8_LDA(At, 0, 0); PG8_STAGE(PG8_SA(1, 1), a1 + hstep, voffA);
            PG8_WAIT_V(8); PG8_WAIT_L(0); PG8_BAR; PG8_MMA(0, 0, At, B0); PG8_MMA(0, 1, At, B1); PG8_BAR; PG8_SCHED;
            PG8_LDA(At, 0, 1); PG8_STAGE(PG8_SB(0, 0), b2, voffB); PG8_STAGE(PG8_SB(0, 1), b2 + hstep, voffB); PG8_STAGE(PG8_SA(0, 0), a2, voffA);
            PG8_WAIT_V(8); PG8_WAIT_L(0); PG8_BAR; PG8_MMA(1, 0, At, B0); PG8_MMA(1, 1, At, B1); PG8_BAR; PG8_SCHED;
            PG8_LDB(B0, 1, 0); PG8_LDB(B1, 1, 1); PG8_SCHED; PG8_LDA(At, 1, 0); PG8_STAGE(PG8_SA(0, 1), a2 + hstep, voffA);
            PG8_WAIT_V(8); PG8_WAIT_L(0); PG8_BAR; PG8_MMA(0, 0, At, B0); PG8_MMA(0, 1, At, B1); PG8_BAR; PG8_SCHED;
            PG8_LDA(At, 1, 1); PG8_STAGE(PG8_SB(1, 0), b3, voffB); PG8_STAGE(PG8_SB(1, 1), b3 + hstep, voffB); PG8_STAGE(PG8_SA(1, 0), a3, voffA);
            PG8_WAIT_V(8); PG8_WAIT_L(0); PG8_BAR; PG8_MMA(1, 0, At, B0); PG8_MMA(1, 1, At, B1); PG8_BAR; PG8_SCHED;
        }
        if (wr == 0) PG8_BAR;
        E(acc, cur, wr, wc, fr, fq);
        if (!has_next) break;
#pragma unroll
        for (int a = 0; a < 2; ++a)
#pragma unroll
            for (int b = 0; b < 2; ++b)
#pragma unroll
                for (int m = 0; m < 4; ++m)
#pragma unroll
                    for (int n = 0; n < 2; ++n) acc[a][b][m][n] = (f32x4){0.f, 0.f, 0.f, 0.f};
        cur = nxt; cA = nA; cB = nB; ++ui;
        if (wr == 1) PG8_BAR;
    }
    PG8_WAIT_V(0);
    PG8_BAR;
#undef PG8_SA
#undef PG8_SB
#undef PG8_STAGE
#undef PG8_LDA
#undef PG8_LDB
#undef PG8_MMA
#undef PG8_WAIT_V
#undef PG8_WAIT_L
#undef PG8_BAR
#undef PG8_SCHED
}
}

__device__ __forceinline__ size_t oidx(int row, int k, int K, bool permB) {
    int r = row & 127;
    if (permB) { const int c32 = r & 31; r = (r & ~31) + 16 * ((c32 >> 2) & 1) + 4 * (c32 >> 3) + (c32 & 3); }
    const size_t blk = ((size_t)(row >> 8) * (K >> 6) + (k >> 6)) * 2 + ((row >> 7) & 1);
    return blk * 8192 + (size_t)(pg8::lds_byte(r, k & 63) >> 1);
}

struct EpiAll {
    int mode; bf16_t* O; int ldc; int sig_from; int gcol0; float* T; bf16_t* Mout; const float* Xin; float* Xout; bf16_t* IKF;
    __device__ __forceinline__ void operator()(const f32x4 (&acc)[2][2][4][2], const pg8::Unit& u, int wr, int wc, int fr, int fq) const {
        const int row0 = u.pm * 256 + wr * 64 + fr, col0 = u.pn * 256 + wc * 32 + 8 * fq;
        if (mode == 0) {
            for (int dup_ = 0; dup_ < 1 + ((PROBE_DUP >> 7) & 1); ++dup_)
#pragma unroll
            for (int bj = 0; bj < 2; ++bj) {
                const bool sg = (u.pn * 2 + bj) >= sig_from;
                const int col = col0 + bj * 128;
#pragma unroll
                for (int ai = 0; ai < 2; ++ai)
#pragma unroll
                    for (int m = 0; m < 4; ++m) { const size_t row = (size_t)(row0 + ai * 128 + m * 16);
                        f32x4 v0 = acc[ai][bj][m][0], v1 = acc[ai][bj][m][1];
                        if (sg) {
#pragma unroll
                            for (int j = 0; j < 4; ++j) { v0[j] = sigmoidf_(v0[j]); v1[j] = sigmoidf_(v1[j]); } }
                        u32x4 w; w.x = cvt_pk_bf16(v0[0], v0[1]); w.y = cvt_pk_bf16(v0[2], v0[3]); w.z = cvt_pk_bf16(v1[0], v1[1]); w.w = cvt_pk_bf16(v1[2], v1[3]);
                        *(u32x4*)(O + pidx((int)row, col)) = w;
                        if (col >= IK && col < IK + 64) {
                            const int kg = (col - IK) >> 3;
                            *(u32x4*)(IKF + ((row >> 5) * 4 + (kg >> 1)) * 512 + (((int)row & 31) + 32 * (kg & 1)) * 8) = w; }
                    }
            }
        } else if (mode <= 3) {
            u32x4 gw[2], tw[2], gn[2], tn[2], gm[2], tm[2];
#define EPI_LD(s_, G_, T_) do { const int bj_ = (s_) >> 2, ai_ = ((s_) >> 1) & 1, mb_ = ((s_) & 1) * 2; \
                _Pragma("unroll") for (int mm = 0; mm < 2; ++mm) { const size_t row = (size_t)(row0 + ai_ * 128 + (mb_ + mm) * 16); const int col = col0 + bj_ * 128; \
                    G_[mm] = *(const u32x4*)(O + pidx((int)row, gcol0 + col)); if (mode >= 2) T_[mm] = *(const u32x4*)(Mout + oidx((int)row, col, DM, false)); } } while (0)
            EPI_LD(0, gw, tw); EPI_LD(1, gn, tn);
#pragma unroll
            for (int s = 0; s < 8; ++s) { const int bj = s >> 2, ai = (s >> 1) & 1, mb = (s & 1) * 2, col = col0 + bj * 128;
                if (s < 6) EPI_LD(s + 2, gm, tm);
                asm volatile("" ::: "memory");
#pragma unroll
                for (int mm = 0; mm < 2; ++mm) { const int m = mb + mm; const size_t row = (size_t)(row0 + ai * 128 + m * 16);
                    f32x4 v0 = acc[ai][bj][m][0], v1 = acc[ai][bj][m][1];
                    v0[0] *= bf_lo(gw[mm].x); v0[1] *= bf_hi(gw[mm].x); v0[2] *= bf_lo(gw[mm].y); v0[3] *= bf_hi(gw[mm].y);
                    v1[0] *= bf_lo(gw[mm].z); v1[1] *= bf_hi(gw[mm].z); v1[2] *= bf_lo(gw[mm].w); v1[3] *= bf_hi(gw[mm].w);
                    if (mode >= 2) { v0[0] += bf_lo(tw[mm].x); v0[1] += bf_hi(tw[mm].x); v0[2] += bf_lo(tw[mm].y); v0[3] += bf_hi(tw[mm].y);
                        v1[0] += bf_lo(tw[mm].z); v1[1] += bf_hi(tw[mm].z); v1[2] += bf_lo(tw[mm].w); v1[3] += bf_hi(tw[mm].w); }
                    u32x4 w; w.x = cvt_pk_bf16(v0[0], v0[1]); w.y = cvt_pk_bf16(v0[2], v0[3]); w.z = cvt_pk_bf16(v1[0], v1[1]); w.w = cvt_pk_bf16(v1[2], v1[3]);
                    *(u32x4*)(Mout + oidx((int)row, col, DM, false)) = w; }
                asm volatile("" ::: "memory");
#pragma unroll
                for (int mm = 0; mm < 2; ++mm) { gw[mm] = gn[mm]; tw[mm] = tn[mm]; gn[mm] = gm[mm]; tn[mm] = tm[mm]; }
            }
#undef EPI_LD
        } else {
            f32x4 xa[2], xb[2], xan[2], xbn[2];
#define EPI_LD(s_, A_, B_) do { const int bj_ = (s_) >> 2, ai_ = ((s_) >> 1) & 1, mb_ = ((s_) & 1) * 2; \
                _Pragma("unroll") for (int mm = 0; mm < 2; ++mm) { const size_t o = (size_t)(row0 + ai_ * 128 + (mb_ + mm) * 16) * DM + col0 + bj_ * 128; \
                    A_[mm] = *(const f32x4*)(Xin + o); B_[mm] = *(const f32x4*)(Xin + o + 4); } } while (0)
            EPI_LD(0, xa, xb);
#pragma unroll
            for (int s = 0; s < 8; ++s) { const int bj = s >> 2, ai = (s >> 1) & 1, mb = (s & 1) * 2;
                if (s < 7) EPI_LD(s + 1, xan, xbn);
                asm volatile("" ::: "memory");
#pragma unroll
                for (int mm = 0; mm < 2; ++mm) { const size_t o = (size_t)(row0 + ai * 128 + (mb + mm) * 16) * DM + col0 + bj * 128;
                    *(f32x4*)(Xout + o) = xa[mm] + acc[ai][bj][mb + mm][0]; *(f32x4*)(Xout + o + 4) = xb[mm] + acc[ai][bj][mb + mm][1]; }
                asm volatile("" ::: "memory");
#pragma unroll
                for (int mm = 0; mm < 2; ++mm) { xa[mm] = xan[mm]; xb[mm] = xbn[mm]; }
            }
#undef EPI_LD
        }
    }
};

__device__ __forceinline__ void tcvt_load(const float* __restrict__ src, int ld_src, int k0, int n0, int mode, f32x4 (&v)[2]) {
    const int tid = otid();
#pragma unroll
    for (int i = 0; i < 2; ++i) {
        const int idx = tid + 512 * i, kk = idx >> 4, nq = idx & 15, n = n0 + 4 * nq;
        int sc = n; bool valid = true;
        if (mode == 1) { if (n < 12368) sc = n; else if (n < 12416) valid = false; else if (n < 18560) sc = n - 48; else valid = false; }
        v[i] = (f32x4){0.f, 0.f, 0.f, 0.f};
        if (valid) v[i] = *(const f32x4*)(src + (size_t)(k0 + kk) * ld_src + sc);
    }
}
__device__ __forceinline__ void tcvt_lds_write(const f32x4 (&v)[2], float* tile) {
    const int tid = otid();
#pragma unroll
    for (int i = 0; i < 2; ++i) { const int idx = tid + 512 * i, kk = idx >> 4, nq = idx & 15;
        float* tp = tile + kk * 65 + 4 * nq; tp[0] = v[i][0]; tp[1] = v[i][1]; tp[2] = v[i][2]; tp[3] = v[i][3]; }
}
__device__ __forceinline__ void tcvt_store(bf16_t* __restrict__ dst, int K, int k0, int n0, const float* tile) {
    const int tid = otid();
    const int n = tid >> 3, kc = tid & 7; const float* tp = tile + (kc * 8) * 65 + n;
    u32x4 w; w.x = cvt_pk_bf16(tp[0], tp[65]); w.y = cvt_pk_bf16(tp[130], tp[195]); w.z = cvt_pk_bf16(tp[260], tp[325]); w.w = cvt_pk_bf16(tp[390], tp[455]);
    *(u32x4*)(dst + oidx(n0 + n, k0 + kc * 8, K, true)) = w;
}

__device__ __forceinline__ void rmsnorm_rows(const float* __restrict__ X, const float* __restrict__ g, bf16_t* __restrict__ H, float* __restrict__ Out) {
    const int lane = otid() & 63, gw = blockIdx.x * 8 + (otid() >> 6), nw = gridDim.x * 8;
    for (int row = gw; row < MT; row += nw) {
        const f32x4* xr = (const f32x4*)(X + (size_t)row * DM);
        f32x4 v[8]; float ss = 0.f;
#pragma unroll
        for (int i = 0; i < 8; ++i) { v[i] = xr[lane + 64 * i]; ss += v[i][0] * v[i][0] + v[i][1] * v[i][1] + v[i][2] * v[i][2] + v[i][3] * v[i][3]; }
#pragma unroll
        for (int o = 32; o >= 1; o >>= 1) ss += __shfl_xor(ss, o);
        const float rstd = rsqrtf(ss * (1.0f / DM) + 1e-6f);
#pragma unroll
        for (int i = 0; i < 8; ++i) { const f32x4 gg = *(const f32x4*)(g + 4 * (lane + 64 * i));
            const float a = v[i][0] * rstd * gg[0], b = v[i][1] * rstd * gg[1], c = v[i][2] * rstd * gg[2], d = v[i][3] * rstd * gg[3];
            if (H) { u32x2 w; w.x = cvt_pk_bf16(a, b); w.y = cvt_pk_bf16(c, d); *(u32x2*)(H + oidx(row, 4 * (lane + 64 * i), DM, false)) = w; }
            else { *(f32x4*)(Out + (size_t)row * DM + 4 * (lane + 64 * i)) = (f32x4){a, b, c, d}; } }
    }
}

__device__ __forceinline__ void convert_layer(const Params& p, float* tile, int l, int bid, int nb) {
    int base = 0;
    for (int kind = 0; kind < 5; ++kind) {
        const float* src; bf16_t* dst; int ld_src, K, ntn, mode = 0;
        if (kind == 0) { src = p.w_in + (size_t)l * DM * INC; dst = (bf16_t*)(p.ws + WS_WTIN + SZ_WTIN1 * l); ld_src = INC; K = DM; ntn = NP / 64; mode = 1; }
        else if (kind == 4) { src = p.w_o + (size_t)l * DM * DM; dst = (bf16_t*)(p.ws + WS_WTO + SZ_WTO1 * l); ld_src = DM; K = DM; ntn = DM / 64; }
        else { const float* s3 = kind == 1 ? p.p_a : (kind == 2 ? p.p_b : p.p_c); const size_t o3 = kind == 1 ? WS_WTPA : (kind == 2 ? WS_WTPB : WS_WTPC);
            src = s3 + (size_t)l * 1024 * DM; dst = (bf16_t*)(p.ws + o3 + SZ_WTP1 * l); ld_src = DM; K = 1024; ntn = DM / 64; }
        const int cnt = ntn * (K / 64);
        int first = (bid - base) % nb; if (first < 0) first += nb;
        f32x4 v[2];
        if (first < cnt) tcvt_load(src, ld_src, (first / ntn) * 64, (first % ntn) * 64, mode, v);
        for (int j = first; j < cnt; j += nb) {
            const int kt = j / ntn, nt = j % ntn;
            tcvt_lds_write(v, tile);
            __syncthreads();
            if (j + nb < cnt) tcvt_load(src, ld_src, ((j + nb) / ntn) * 64, ((j + nb) % ntn) * 64, mode, v);
            tcvt_store(dst, K, kt * 64, nt * 64, tile);
            __syncthreads();
        }
        base += cnt;
    }
}

__device__ __forceinline__ void phase_prep(const Params& p, unsigned char* smem) {
    float* tile = (float*)smem;
    const int bid = blockIdx.x, nb = gridDim.x;
    convert_layer(p, tile, 0, bid, nb);
    { bf16_t* aw = (bf16_t*)(p.ws + WS_AWS); const int n = DEPTH * 8 * 128 * 128;
      for (int i = bid * 512 + otid(); i < n; i += nb * 512) { const int s = i & 127, t = (i >> 7) & 127; const float v = (s <= t) ? p.a_ws[i] : 0.f; aw[i] = (bf16_t)(cvt_pk_bf16(v, 0.f) & 0xffffu); } }
    rmsnorm_rows(p.x, p.norm_g, (bf16_t*)(p.ws + WS_H), nullptr);
}

__device__ __forceinline__ void isel_item(const Params& p, int item, unsigned char* smem) {
    const bf16_t* P = (const bf16_t*)(p.ws + WS_P); unsigned long long* MK = (unsigned long long*)(p.ws + WS_MASK);
    unsigned* SU = (unsigned*)smem;
    const int tid = otid(), lane = tid & 63, w = __builtin_amdgcn_readfirstlane(tid >> 6), hh = lane >> 5, l31 = lane & 31;
    const int b = item >> 9, t0 = (((item >> 8) & 1) ? 511 - (item & 255) : (item & 255)) * 8;
    const int nkt = ((t0 + 7) >> 5) + 1;
    {
        bf16x8 Af[4][4]; float wv[4][16];
        const int qq = (l31 >> 2) & 1, hd = (l31 & 3) + 4 * (l31 >> 3);
#pragma unroll
        for (int rt = 0; rt < 4; ++rt) {
#pragma unroll
            for (int ks = 0; ks < 4; ++ks) Af[rt][ks] = *(const bf16x8*)(P + pidx(b * SL + t0 + 2 * rt + qq, IQ + hd * 64 + ks * 16 + hh * 8));
            const u32x4* wp = (const u32x4*)(P + pidx(b * SL + t0 + 2 * rt + hh, IW));
            const u32x4 w0 = wp[0], w1 = wp[1];
            const float sc = 1.0f / 32.0f;
            wv[rt][0] = bf_lo(w0.x) * sc; wv[rt][1] = bf_hi(w0.x) * sc; wv[rt][2] = bf_lo(w0.y) * sc; wv[rt][3] = bf_hi(w0.y) * sc;
            wv[rt][4] = bf_lo(w0.z) * sc; wv[rt][5] = bf_hi(w0.z) * sc; wv[rt][6] = bf_lo(w0.w) * sc; wv[rt][7] = bf_hi(w0.w) * sc;
            wv[rt][8] = bf_lo(w1.x) * sc; wv[rt][9] = bf_hi(w1.x) * sc; wv[rt][10] = bf_lo(w1.y) * sc; wv[rt][11] = bf_hi(w1.y) * sc;
            wv[rt][12] = bf_lo(w1.z) * sc; wv[rt][13] = bf_hi(w1.z) * sc; wv[rt][14] = bf_lo(w1.w) * sc; wv[rt][15] = bf_hi(w1.w) * sc; }
        const bf16_t* kb = (const bf16_t*)(p.ws + WS_IKF) + (size_t)(b * (SL / 32)) * 2048 + lane * 8;
        bf16x8 Bf[4];
        if (w < nkt) {
#pragma unroll
            for (int ks = 0; ks < 4; ++ks) Bf[ks] = *(const bf16x8*)(kb + (size_t)w * 2048 + ks * 512);
        }
        for (int j = w; j < nkt; j += 8) {
            f32x16 acc[4];
#pragma unroll
            for (int rt = 0; rt < 4; ++rt) acc[rt] = (f32x16){};
#pragma unroll
            for (int ks = 0; ks < 4; ++ks)
#pragma unroll
                for (int rt = 0; rt < 4; ++rt) acc[rt] = __builtin_amdgcn_mfma_f32_32x32x16_bf16(Af[rt][ks], Bf[ks], acc[rt], 0, 0, 0);
            if (j + 8 < nkt) {
#pragma unroll
                for (int ks = 0; ks < 4; ++ks) Bf[ks] = *(const bf16x8*)(kb + (size_t)(j + 8) * 2048 + ks * 512);
            }
            const int key = 32 * j + l31;
#pragma unroll
            for (int rt = 0; rt < 4; ++rt) {
                float sv = 0.f;
#pragma unroll
                for (int q = 0; q < 16; ++q) sv += wv[rt][q] * fmaxf(acc[rt][q], 0.f);
                const int qi = 2 * rt + hh;
                const unsigned bits = __float_as_uint(sv);
                const unsigned uu = bits ^ ((bits >> 31) ? 0xffffffffu : 0x80000000u);
                SU[qi * 4096 + key] = (key <= t0 + qi) ? uu : 0u;
            }
        }
    }
    __syncthreads();
    {
        const int t = t0 + w, njw = (t >> 6) + 1, q = b * SL + t;
        const unsigned* row = SU + w * 4096;
        unsigned u[64];
#pragma unroll
        for (int jb = 0; jb < 8; ++jb) {
            if (jb * 8 < njw) {
#pragma unroll
                for (int jj = 0; jj < 8; ++jj) { const int j = jb * 8 + jj, key = 64 * j + lane; u[j] = (key <= t) ? row[key] : 0u; }
            } else {
#pragma unroll
                for (int jj = 0; jj < 8; ++jj) u[jb * 8 + jj] = 0;
            }
        }
        unsigned T = 1u; bool exact = true; int need = 0;
        if (t >= 256) {
            unsigned* hist = SU + w * 4096;
#pragma unroll
            for (int i = 0; i < 16; ++i) *(u32x4*)(hist + 4 * (lane + 64 * i)) = (u32x4){0u, 0u, 0u, 0u};
            asm volatile("" ::: "memory");
#pragma unroll
            for (int jb = 0; jb < 8; ++jb) if (jb * 8 < njw) {
#pragma unroll
                for (int jj = 0; jj < 8; ++jj) { const unsigned v = u[jb * 8 + jj];
                    __hip_atomic_fetch_add(hist + (v ? (v >> 20) : (unsigned)lane), 1u, __ATOMIC_RELAXED, __HIP_MEMORY_SCOPE_WORKGROUP); } }
            asm volatile("" ::: "memory");
            int sl = 0;
#pragma unroll
            for (int i = 0; i < 16; ++i) { const u32x4 h4 = *(const u32x4*)(hist + 64 * lane + 4 * i); sl += (int)(h4.x + h4.y + h4.z + h4.w); }
            int suf = sl;
#pragma unroll
            for (int o = 1; o < 64; o <<= 1) { const int v = __shfl_down(suf, o); if (lane + o < 64) suf += v; }
            const unsigned long long okm = __ballot(suf >= 256);
            const int Lh = 63 - __clzll(okm);
            const int sufL = __shfl(suf, Lh), slL = __shfl(sl, Lh);
            const int above = sufL - slL;
            int hs = (int)hist[64 * Lh + lane];
#pragma unroll
            for (int o = 1; o < 64; o <<= 1) { const int v = __shfl_down(hs, o); if (lane + o < 64) hs += v; }
            const unsigned long long okb = __ballot(hs + above >= 256);
            const int Ib = 63 - __clzll(okb);
            T = (unsigned)(64 * Lh + Ib) << 20; exact = false;
            for (int bit = 19; bit >= 0; --bit) {
                const unsigned cand = T | (1u << bit); int cl = 0;
#pragma unroll
                for (int jb = 0; jb < 8; ++jb) if (jb * 8 < njw) {
#pragma unroll
                    for (int jj = 0; jj < 8; ++jj) cl += (u[jb * 8 + jj] >= cand) ? 1 : 0; }
                int cnt = 0;
#pragma unroll
                for (int bb = 0; bb < 7; ++bb) cnt += __popcll(__ballot((cl >> bb) & 1)) << bb;
                if (cnt >= 256) { T = cand; if (cnt == 256) { exact = true; break; } }
            }
            if (!exact) { int cgt = 0;
#pragma unroll
                for (int j = 0; j < 64; ++j) cgt += __popcll(__ballot(u[j] > T));
                need = 256 - cgt; }
        }
        unsigned long long myw = 0;
        if (exact) {
#pragma unroll
            for (int j = 0; j < 64; ++j) { const unsigned long long m = __ballot(u[j] >= T); if (lane == j) myw = m; }
        } else {
#pragma unroll
            for (int j = 0; j < 64; ++j) {
                const unsigned long long gt = __ballot(u[j] > T); unsigned long long eq = __ballot(u[j] == T);
                while (__popcll(eq) > need) eq &= ~(1ull << (63 - __clzll(eq)));
                need -= __popcll(eq);
                const unsigned long long m = gt | eq; if (lane == j) myw = m; }
        }
        MK[(size_t)q * 64 + lane] = myw;
    }
    __syncthreads();
}

__device__ __forceinline__ void sgu_item(const Params& p, int layer, int item, unsigned char* smem) {
    const bf16_t* P = (const bf16_t*)(p.ws + WS_P); bf16_t* YA = (bf16_t*)(p.ws + WS_YA);
    const bf16_t* aws = (const bf16_t*)(p.ws + WS_AWS + SZ_AWS1 * layer);
    const int tid = otid(), lane = tid & 63, w = tid >> 6, hh = lane >> 5, l31 = lane & 31;
    const int b = item >> 8, n = (item >> 3) & 31, g = item & 7, tok0 = b * SL + n * 128;
#pragma unroll
    for (int i = 0; i < 4; ++i) { const int ch = tid + 512 * i, c8 = ch >> 7, s = ch & 127;
        const u32x4 v = *(const u32x4*)(P + pidx(tok0 + s, AV + g * 128 + c8 * 8));
        unsigned char* d = smem + (c8 * 8) * 272 + s * 2;
        *(bf16_t*)(d + 0 * 272) = (bf16_t)(v.x & 0xffff); *(bf16_t*)(d + 1 * 272) = (bf16_t)(v.x >> 16);
        *(bf16_t*)(d + 2 * 272) = (bf16_t)(v.y & 0xffff); *(bf16_t*)(d + 3 * 272) = (bf16_t)(v.y >> 16);
        *(bf16_t*)(d + 4 * 272) = (bf16_t)(v.z & 0xffff); *(bf16_t*)(d + 5 * 272) = (bf16_t)(v.z >> 16);
        *(bf16_t*)(d + 6 * 272) = (bf16_t)(v.w & 0xffff); *(bf16_t*)(d + 7 * 272) = (bf16_t)(v.w >> 16); }
    __syncthreads();
    const int tt = w & 3, cp = w >> 2, t = 32 * tt + l31, tok = tok0 + t;
    const float bias = p.a_b[(size_t)(layer * 8 + g) * 128 + t];
    const bf16_t* wsrow = aws + ((size_t)g * 128 + t) * 128 + hh * 8;
#pragma unroll
    for (int ci = 0; ci < 2; ++ci) {
        const int ct = cp * 2 + ci;
        f32x16 acc = {};
        for (int ks = 0; ks < 2 * (tt + 1); ++ks) {
            const bf16x8 A = *(const bf16x8*)(smem + (32 * ct + l31) * 272 + (ks * 16 + hh * 8) * 2);
            const bf16x8 Bv = *(const bf16x8*)(wsrow + ks * 16);
            acc = __builtin_amdgcn_mfma_f32_32x32x16_bf16(A, Bv, acc, 0, 0, 0);
        }
#pragma unroll
        for (int q4 = 0; q4 < 4; ++q4) {
            const int c = g * 128 + 32 * ct + 8 * q4 + 4 * hh;
            const u32x2 u4 = *(const u32x2*)(P + pidx(tok, AU + c)), z4 = *(const u32x2*)(P + pidx(tok, AZ + c));
            const float y0 = bf_lo(u4.x) * (acc[4 * q4 + 0] + bias) * siluf_(bf_lo(z4.x));
            const float y1 = bf_hi(u4.x) * (acc[4 * q4 + 1] + bias) * siluf_(bf_hi(z4.x));
            const float y2 = bf_lo(u4.y) * (acc[4 * q4 + 2] + bias) * siluf_(bf_lo(z4.y));
            const float y3 = bf_hi(u4.y) * (acc[4 * q4 + 3] + bias) * siluf_(bf_hi(z4.y));
            u32x2 o; o.x = cvt_pk_bf16(y0, y1); o.y = cvt_pk_bf16(y2, y3);
            *(u32x2*)(YA + oidx(tok, c, 1024, false)) = o;
        }
    }
    __syncthreads();
}

__device__ __forceinline__ void vt_item(const Params& p, int item, unsigned char* smem) {
    const bf16_t* P = (const bf16_t*)(p.ws + WS_P); bf16_t* VT = (bf16_t*)(p.ws + WS_VT);
    const int tid = otid();
    const int b = item >> 9, h = (item >> 6) & 7, st = item & 63;
#pragma unroll
    for (int i = 0; i < 2; ++i) { const int ch = tid + 512 * i, d8 = ch >> 6, s = ch & 63;
        const u32x4 v = *(const u32x4*)(P + pidx(b * SL + st * 64 + s, CV + h * 128 + d8 * 8));
        unsigned char* d = smem + (d8 * 8) * 144 + s * 2;
        *(bf16_t*)(d + 0 * 144) = (bf16_t)(v.x & 0xffff); *(bf16_t*)(d + 1 * 144) = (bf16_t)(v.x >> 16);
        *(bf16_t*)(d + 2 * 144) = (bf16_t)(v.y & 0xffff); *(bf16_t*)(d + 3 * 144) = (bf16_t)(v.y >> 16);
        *(bf16_t*)(d + 4 * 144) = (bf16_t)(v.z & 0xffff); *(bf16_t*)(d + 5 * 144) = (bf16_t)(v.z >> 16);
        *(bf16_t*)(d + 6 * 144) = (bf16_t)(v.w & 0xffff); *(bf16_t*)(d + 7 * 144) = (bf16_t)(v.w >> 16); }
    __syncthreads();
#pragma unroll
    for (int i = 0; i < 2; ++i) { const int ch = tid + 512 * i, d = ch >> 3, c16 = ch & 7;
        const u32x4 v = *(const u32x4*)(smem + d * 144 + c16 * 16);
        *(u32x4*)(VT + ((size_t)((b * 8 + h) * 128 + d)) * SL + st * 64 + c16 * 8) = v; }
    __syncthreads();
}

__device__ __forceinline__ void conv_item(const Params& p, int layer, int item) {
    const bf16_t* P = (const bf16_t*)(p.ws + WS_P); bf16_t* YB = (bf16_t*)(p.ws + WS_YB);
    const float* cw = p.b_conv + (size_t)layer * 3 * 1024;
    const int tid = otid();
#pragma unroll
    for (int i = 0; i < 4; ++i) {
        const int idx = tid + 512 * i, tk = idx >> 7, c = (idx & 127) * 8, tok = item * 16 + tk, tpos = tok & (SL - 1);
        const u32x4 bg = *(const u32x4*)(P + pidx(tok, BB + c)), zz = *(const u32x4*)(P + pidx(tok, BZ + c));
        const u32x4 c0 = *(const u32x4*)(P + pidx(tok, BC + c)), x0 = *(const u32x4*)(P + pidx(tok, BX + c));
        u32x4 c1 = (u32x4){0, 0, 0, 0}, x1 = c1, c2 = c1, x2 = c1;
        if (tpos >= 1) { c1 = *(const u32x4*)(P + pidx(tok - 1, BC + c)); x1 = *(const u32x4*)(P + pidx(tok - 1, BX + c)); }
        if (tpos >= 2) { c2 = *(const u32x4*)(P + pidx(tok - 2, BC + c)); x2 = *(const u32x4*)(P + pidx(tok - 2, BX + c)); }
        float y[8];
#pragma unroll
        for (int e = 0; e < 8; ++e) {
            const int wi = e >> 1; const bool hi = e & 1;
            const unsigned bgw = bg[wi], zw = zz[wi], c0w = c0[wi], x0w = x0[wi], c1w = c1[wi], x1w = x1[wi], c2w = c2[wi], x2w = x2[wi];
            const float fb = hi ? bf_hi(bgw) : bf_lo(bgw), fz = hi ? bf_hi(zw) : bf_lo(zw);
            const float a0 = (hi ? bf_hi(c0w) : bf_lo(c0w)) * (hi ? bf_hi(x0w) : bf_lo(x0w));
            const float a1 = (hi ? bf_hi(c1w) : bf_lo(c1w)) * (hi ? bf_hi(x1w) : bf_lo(x1w));
            const float a2 = (hi ? bf_hi(c2w) : bf_lo(c2w)) * (hi ? bf_hi(x2w) : bf_lo(x2w));
            const float cv = cw[2048 + c + e] * a0 + cw[1024 + c + e] * a1 + cw[c + e] * a2;
            y[e] = fb * cv * siluf_(fz);
        }
        u32x4 o; o.x = cvt_pk_bf16(y[0], y[1]); o.y = cvt_pk_bf16(y[2], y[3]); o.z = cvt_pk_bf16(y[4], y[5]); o.w = cvt_pk_bf16(y[6], y[7]);
        *(u32x4*)(YB + oidx(tok, c, 1024, false)) = o;
    }
}

__device__ __forceinline__ void phase_mixprep(const Params& p, int layer, unsigned char* smem) {
    constexpr int nI = 2048, nA = 1024, nV = 2048, nC = 1024;
    for (int j = blockIdx.x; j < nI + nA + nV + nC; j += gridDim.x) {
        if (j < nI) { for (int d = 0; d < 1 + ((PROBE_MIX >> 0) & 1); ++d) isel_item(p, j, smem); }
        else if (j < nI + nA) { for (int d = 0; d < 1 + ((PROBE_MIX >> 1) & 1); ++d) sgu_item(p, layer, j - nI, smem); }
        else if (j < nI + nA + nV) { for (int d = 0; d < 1 + ((PROBE_MIX >> 2) & 1); ++d) vt_item(p, j - nI - nA, smem); }
        else { for (int d = 0; d < 1 + ((PROBE_MIX >> 3) & 1); ++d) conv_item(p, layer, j - nI - nA - nV); }
    }
}

__device__ __forceinline__ int swap23(int i) { return (i & ~12) | ((i & 4) << 1) | ((i & 8) >> 1); }

__device__ __forceinline__ void phase_attn(const Params& p, unsigned char* smem) {
    const bf16_t* P = (const bf16_t*)(p.ws + WS_P); const bf16_t* VT = (const bf16_t*)(p.ws + WS_VT); bf16_t* YC = (bf16_t*)(p.ws + WS_YC);
    const unsigned long long* MK = (const unsigned long long*)(p.ws + WS_MASK);
    const int tid = otid(), lane = tid & 63, w = __builtin_amdgcn_readfirstlane(tid >> 6), hh = lane >> 5, l31 = lane & 31;
    constexpr int STG = 32768, KOFF = 0, VOFF = 16384;
    LAS unsigned char* lds = (LAS unsigned char*)smem;
    float* biasL = (float*)(smem + 3 * STG);
    constexpr float LOG2E = 1.4426950408889634f;
    const float sc = 0.08838834764831845f * LOG2E;
    int kro[2], vro[4];
#pragma unroll
    for (int c2 = 0; c2 < 2; ++c2) kro[c2] = (32 * c2 + swap23(l31)) * 256;
    const int krx = swap23(l31) & 15;
    const int vrx = (l31 >> 1) & 7;
#define ATT_WAIT_V(n) asm volatile("s_waitcnt vmcnt(" #n ")" ::: "memory")
#define ATT_ISSUE(kt_, stg_) do { const char* vg_ = (const char*)Vg + (size_t)(kt_) * 128; \
        int li_ = lane; asm volatile("" : "+v"(li_)); \
        _Pragma("unroll") for (int i_ = 0; i_ < 2; ++i_) { const int n_ = w + 8 * i_; \
            const int kr_ = 4 * n_ + (li_ >> 4), kc_ = (li_ & 15) ^ (kr_ & 15); const char* kga_ = (const char*)(P + pidx(b * SL + (kt_) * 64 + kr_, CK + h * 128 + kc_ * 8)); \
            const int vd_ = 8 * n_ + (li_ >> 3), vc_ = (li_ & 7) ^ ((vd_ >> 1) & 7); const unsigned vgo_ = (unsigned)(vd_ * SL * 2 + vc_ * 16); \
            __builtin_amdgcn_global_load_lds((const unsigned*)(kga_), (LAS unsigned*)(lds + (stg_) * STG + KOFF + n_ * 1024), 16, 0, 0); \
            __builtin_amdgcn_global_load_lds((const unsigned*)(vg_ + vgo_), (LAS unsigned*)(lds + (stg_) * STG + VOFF + n_ * 1024), 16, 0, 0); } } while (0)
    for (int item = blockIdx.x; item < 256; item += gridDim.x) {
        const int bh = (item & 7) + 8 * (item >> 6), pr = (item >> 3) & 7, b = bh >> 3, h = bh & 7;
        __syncthreads();
        if (tid < 129) { int bk = tid; if (tid >= 16) { bk = 16 + (int)(logf((float)tid * 0.0625f) / 2.0794415416798357f * 16.0f); bk = bk > 31 ? 31 : bk; } if (tid >= 128) bk = 31;
            biasL[tid] = (p.rel_bias[bk * 8 + h] - p.rel_bias[31 * 8 + h]) * LOG2E; }
        __syncthreads();
        const bf16_t* Vg = VT + (size_t)((b * 8 + h) * 128) * SL;
        for (int si = 0; si < 2; ++si) {
            const int qt = si ? pr : 15 - pr, q0 = qt * 256, tq = q0 + 32 * w + l31, tokq = b * SL + tq;
            const int nkt = (q0 + 256) >> 6, wlast = (q0 + 32 * w + 31) >> 6;
            bf16x8 Qf[8];
#pragma unroll
            for (int ks = 0; ks < 8; ++ks) { const u32x4 q4 = *(const u32x4*)(P + pidx(tokq, CQ + h * 128 + ks * 16 + hh * 8));
                u32x4 qs; qs.x = cvt_pk_bf16(bf_lo(q4.x) * sc, bf_hi(q4.x) * sc); qs.y = cvt_pk_bf16(bf_lo(q4.y) * sc, bf_hi(q4.y) * sc);
                qs.z = cvt_pk_bf16(bf_lo(q4.z) * sc, bf_hi(q4.z) * sc); qs.w = cvt_pk_bf16(bf_lo(q4.w) * sc, bf_hi(q4.w) * sc);
                __builtin_memcpy(&Qf[ks], &qs, 16); }
            const unsigned long long* mrow = MK + (size_t)tokq * 64;
            unsigned long long mnext = mrow[0];
            ATT_WAIT_V(0);
            ATT_ISSUE(0, 0);
            ATT_ISSUE(1, 1);
            f32x16 O[4];
#pragma unroll
            for (int dt = 0; dt < 4; ++dt) O[dt] = (f32x16){};
            float mrun = -1e30f, lsum = 0.f;
            int stg = 0;
            for (int kt = 0; kt < nkt; ++kt) {
                ATT_WAIT_V(4);
                __builtin_amdgcn_s_barrier();
                const unsigned long long mw = mnext;
                if (kt + 1 <= wlast) mnext = mrow[kt + 1];
                { const int k2 = (kt + 2 < nkt) ? kt + 2 : nkt - 1; const int s2 = (stg + 2 >= 3) ? stg - 1 : stg + 2; ATT_ISSUE(k2, s2); }
                if (kt <= wlast) {
                    LAS const unsigned char* Kc = lds + stg * STG + KOFF; LAS const unsigned char* Vc = lds + stg * STG + VOFF;
                    f32x16 sa[2];
#pragma unroll
                    for (int c2 = 0; c2 < 2; ++c2) {
                        sa[c2] = (f32x16){};
#pragma unroll
                        for (int ks = 0; ks < 8; ++ks) sa[c2] = __builtin_amdgcn_mfma_f32_32x32x16_bf16(*(LAS const bf16x8*)(Kc + kro[c2] + (((2 * ks + hh) ^ krx) << 4)), Qf[ks], sa[c2], 0, 0, 0);
                    }
                    const bool far = ((q0 + 32 * w) - (64 * kt + 63)) >= 128;
                    const int dist0 = tq - (64 * kt + 8 * hh);
                    const unsigned mlo = ((unsigned)mw) >> (8 * hh), mhi = ((unsigned)(mw >> 32)) >> (8 * hh);
                    if (!far) {
#pragma unroll
                        for (int c2 = 0; c2 < 2; ++c2)
#pragma unroll
                            for (int r = 0; r < 16; ++r) { int d = dist0 - (32 * c2 + 16 * (r >> 3) + (r & 7)); d = d < 0 ? 0 : (d > 128 ? 128 : d); sa[c2][r] += biasL[d]; }
                    }
                    float mx = fmaxf(sa[0][0], sa[1][0]);
#pragma unroll
                    for (int r = 1; r < 16; ++r) mx = fmaxf(fmaxf(mx, sa[0][r]), sa[1][r]);
                    mx = fmaxf(mx, __shfl_xor(mx, 32));
                    float alpha = 1.0f;
                    const bool grow = __ballot(mx > mrun + 8.0f) != 0ull;
                    if (grow) { const float mnew_ = fmaxf(mrun, mx); alpha = fast_exp2(mrun - mnew_); mrun = mnew_; }
                    const float mnew = mrun;
                    float ps = 0.f;
#pragma unroll
                    for (int c2 = 0; c2 < 2; ++c2)
#pragma unroll
                        for (int r = 0; r < 16; ++r) {
                            const int e = __builtin_amdgcn_sbfe((int)(c2 ? mhi : mlo), 16 * (r >> 3) + (r & 7), 1);
                            const float pv = __uint_as_float(__float_as_uint(fast_exp2(sa[c2][r] - mnew)) & (unsigned)e);
                            sa[c2][r] = pv; ps += pv; }
                    lsum = lsum * alpha + ps;
                    if (grow) {
#pragma unroll
                        for (int dt = 0; dt < 4; ++dt) O[dt] *= alpha;
                    }
#pragma unroll
                    for (int c2 = 0; c2 < 2; ++c2)
#pragma unroll
                        for (int c = 0; c < 2; ++c) {
                            u32x4 pw; pw.x = cvt_pk_bf16(sa[c2][8 * c + 0], sa[c2][8 * c + 1]); pw.y = cvt_pk_bf16(sa[c2][8 * c + 2], sa[c2][8 * c + 3]);
                            pw.z = cvt_pk_bf16(sa[c2][8 * c + 4], sa[c2][8 * c + 5]); pw.w = cvt_pk_bf16(sa[c2][8 * c + 6], sa[c2][8 * c + 7]);
                            bf16x8 Pf; __builtin_memcpy(&Pf, &pw, 16);
                            const int vch = ((4 * c2 + 2 * c + hh) ^ vrx) << 4;
#pragma unroll
                            for (int dt = 0; dt < 4; ++dt) O[dt] = __builtin_amdgcn_mfma_f32_32x32x16_bf16(*(LAS const bf16x8*)(Vc + (32 * dt + l31) * 128 + vch), Pf, O[dt], 0, 0, 0);
                        }
                }
                stg = (stg == 2) ? 0 : stg + 1;
            }
            ATT_WAIT_V(0);
            __builtin_amdgcn_s_barrier();
            lsum += __shfl_xor(lsum, 32);
            const float inv = 1.0f / lsum;
#pragma unroll
            for (int dt = 0; dt < 4; ++dt)
#pragma unroll
                for (int q4 = 0; q4 < 4; ++q4) {
                    const int d = h * 128 + 32 * dt + 8 * q4 + 4 * hh;
                    const u32x2 z4 = *(const u32x2*)(P + pidx(tokq, CZ + d));
                    const float y0 = O[dt][4 * q4 + 0] * inv * siluf_(bf_lo(z4.x)), y1 = O[dt][4 * q4 + 1] * inv * siluf_(bf_hi(z4.x));
                    const float y2 = O[dt][4 * q4 + 2] * inv * siluf_(bf_lo(z4.y)), y3 = O[dt][4 * q4 + 3] * inv * siluf_(bf_hi(z4.y));
                    u32x2 o; o.x = cvt_pk_bf16(y0, y1); o.y = cvt_pk_bf16(y2, y3);
                    *(u32x2*)(YC + oidx(tokq, d, 1024, false)) = o;
                }
        }
    }
#undef ATT_WAIT_V
#undef ATT_ISSUE
}

#define XB_TMO      128
#define XB_XCNT(j)  (256  + 64 * (j))
#define XB_XSUB(j)  (1280 + 64 * (j))
#define XB_XGEN(j)  (2304 + 64 * (j))
#define XB_TOP      3328
#define XB_TOPGEN   3392
#define XCD_BAR_WORDS 3456
#define XB_SPIN_CAP (1u << 18)
__device__ __forceinline__ unsigned xb_ld(unsigned* p)              { return __hip_atomic_load(p, __ATOMIC_RELAXED, __HIP_MEMORY_SCOPE_AGENT); }
__device__ __forceinline__ unsigned xb_add(unsigned* p, unsigned v) { return __hip_atomic_fetch_add(p, v, __ATOMIC_RELAXED, __HIP_MEMORY_SCOPE_AGENT); }
__device__ __forceinline__ unsigned xb_xcc_id() { return (unsigned)__builtin_amdgcn_s_getreg((3 << 11) | 20) & 0xFu; }
#define XB_SPIN(cond, bar) do { unsigned _sp = 0; while (cond) { __builtin_amdgcn_s_sleep(1); \
    if ((++_sp & 255u) == 0u) { if (xb_ld(&(bar)[XB_TMO])) break; if (_sp > XB_SPIN_CAP) { atomicAdd(&(bar)[XB_TMO], 1u); break; } } } } while (0)
struct XcdBarrier { unsigned* bar; unsigned x; volatile LAS unsigned* st; };
__device__ __forceinline__ XcdBarrier xcd_barrier_post(unsigned* bar, volatile LAS unsigned* st) {
    XcdBarrier b; b.bar = bar; b.x = xb_xcc_id(); b.st = st;
    if (__builtin_amdgcn_workitem_id_x() == 0) (void)xb_add(&bar[XB_XCNT(b.x)], 1u);
    return b;
}
__device__ __forceinline__ void xcd_barrier_complete(unsigned* bar, unsigned x, unsigned& nloc, unsigned& nx) {
    const unsigned G = gridDim.x;
    unsigned sum, cnt, mine, sp = 0u;
    for (;;) {
        sum = 0u; cnt = 0u; mine = 0u;
#pragma unroll
        for (unsigned j = 0; j < 16; ++j) { const unsigned c = xb_ld(&bar[XB_XCNT(j)]); sum += c; cnt += (c > 0u) ? 1u : 0u; mine = (j == x) ? c : mine; }
        if (sum == G) break;
        __builtin_amdgcn_s_sleep(1);
        if ((++sp & 255u) == 0u) { if (xb_ld(&bar[XB_TMO])) break; if (sp > XB_SPIN_CAP) { atomicAdd(&bar[XB_TMO], 1u); break; } }
    }
    nloc = mine > 0u ? mine : 1u; nx = cnt > 0u ? cnt : 1u;
}
__device__ __forceinline__ void xcd_barrier(const XcdBarrier& b) {
    asm volatile("s_waitcnt vmcnt(0)" ::: "memory");
    __syncthreads();
    if (__builtin_amdgcn_workitem_id_x() == 0) {
        unsigned* bar = b.bar;
        __builtin_amdgcn_s_waitcnt(0);
        unsigned nloc = b.st[0], nx = b.st[1];
        if (nloc == 0u) { xcd_barrier_complete(bar, b.x, nloc, nx); b.st[0] = nloc; b.st[1] = nx; }
        const unsigned old = xb_add(&bar[XB_XSUB(b.x)], 1u);
        const unsigned gen = old / nloc;
        if (old + 1u == (gen + 1u) * nloc) {
            __builtin_amdgcn_fence(__ATOMIC_RELEASE, "agent");
            asm volatile("s_waitcnt vmcnt(0)" ::: "memory");
            const unsigned og = xb_add(&bar[XB_TOP], 1u);
            const unsigned tg = og / nx;
            if (og + 1u == (tg + 1u) * nx) xb_add(&bar[XB_TOPGEN], 1u);
            else XB_SPIN(xb_ld(&bar[XB_TOPGEN]) == tg, bar);
            __builtin_amdgcn_fence(__ATOMIC_ACQUIRE, "agent");
            xb_add(&bar[XB_XGEN(b.x)], 1u);
            asm volatile("s_waitcnt vmcnt(0)" ::: "memory");
        } else {
            XB_SPIN(xb_ld(&bar[XB_XGEN(b.x)]) == gen, bar);
            __builtin_amdgcn_fence(__ATOMIC_ACQUIRE, "agent");
            asm volatile("s_waitcnt vmcnt(0)" ::: "memory");
        }
    }
    __syncthreads();
}

__device__ __forceinline__ void gemm_call(const Params& p, int layer, int sub, int rep, unsigned char* smem) {
    LAS unsigned char* lds = (LAS unsigned char*)smem;
    bf16_t* H = (bf16_t*)(p.ws + WS_H); bf16_t* P = (bf16_t*)(p.ws + WS_P); float* X = (float*)(p.ws + WS_X);
    pg8::Gemm g; EpiAll E; pg8::StaticOrder S;
    E.O = P; E.ldc = NP; E.IKF = (bf16_t*)(p.ws + WS_IKF); E.sig_from = GA / 128; E.T = (float*)(p.ws + WS_T); E.Mout = (bf16_t*)(p.ws + WS_MM); E.Xin = (layer == 0) ? p.x : X; E.Xout = X; E.gcol0 = GA + rep * DM;
    g.M = MT;
    if (sub == 0) { g.A = H; g.Bt = (const bf16_t*)(p.ws + WS_WTIN + SZ_WTIN1 * layer); g.N = NP; g.K = DM; E.mode = 0; }
    else if (sub == 4) { g.A = (const bf16_t*)(p.ws + WS_YA + (size_t)rep * MT * 1024 * 2); g.Bt = (const bf16_t*)(p.ws + WS_WTPA + SZ_WTP1 * DEPTH * rep + SZ_WTP1 * layer); g.N = DM; g.K = 1024; E.mode = 1 + rep; }
    else { g.A = (const bf16_t*)(p.ws + WS_MM); g.Bt = (const bf16_t*)(p.ws + WS_WTO + SZ_WTO1 * layer); g.N = DM; g.K = DM; E.mode = 4; }
    S.init(MT, g.N, gridDim.x, blockIdx.x);
    pg8::gemm_phase(lds, g, S, E);
    __syncthreads();
}

#if MULTI_LAUNCH
__global__ void __launch_bounds__(512, 2) k_prep(Params p) { extern __shared__ __attribute__((aligned(16))) unsigned char smem[]; phase_prep(p, smem); }
__global__ void __launch_bounds__(512, 2) k_gemm(Params p, int layer, int sub, int rep) { extern __shared__ __attribute__((aligned(16))) unsigned char smem[]; gemm_call(p, layer, sub, rep, smem); }
__global__ void __launch_bounds__(512, 2) k_mix(Params p, int layer) { extern __shared__ __attribute__((aligned(16))) unsigned char smem[]; phase_mixprep(p, layer, smem); }
__global__ void __launch_bounds__(512, 2) k_attn(Params p) { extern __shared__ __attribute__((aligned(16))) unsigned char smem[]; phase_attn(p, smem); }
__global__ void __launch_bounds__(512, 2) k_norm(Params p, int layer) {
    float* X = (float*)(p.ws + WS_X);
    if (layer + 1 < DEPTH) rmsnorm_rows(X, p.norm_g + (size_t)(layer + 1) * DM, (bf16_t*)(p.ws + WS_H), nullptr);
    else rmsnorm_rows(X, p.final_g, nullptr, p.out);
}
#else
__global__ void __launch_bounds__(512, 2) fwd_megakernel(Params p) {
    extern __shared__ __attribute__((aligned(16))) unsigned char smem[];
    cg::grid_group grid = cg::this_grid();
    const int lo = p.ph_lo, hi = p.ph_hi;
    volatile LAS unsigned* xbst = (volatile LAS unsigned*)((LAS unsigned char*)smem + 131072);
    if (__builtin_amdgcn_workitem_id_x() == 0) { xbst[0] = 0u; xbst[1] = 0u; }
    __syncthreads();
    const XcdBarrier xbar = xcd_barrier_post((unsigned*)(p.ws + WS_BAR), xbst);
#define IN(k) (lo <= (k) && (k) < hi)
#define SEAM(k) do { if (IN(k) && IN((k) + 1)) { if ((k) == 0) grid.sync(); else xcd_barrier(xbar); } } while (0)
    for (int dup = 0; dup < 1 + ((PROBE_DUP >> 5) & 1); ++dup) { if (IN(0)) { phase_prep(p, smem); }
    SEAM(0); }
    for (int layer = 0; layer < DEPTH; ++layer) {
        const int b = 1 + 7 * layer;
        for (int dup = 0; dup < 1 + ((PROBE_DUP >> 0) & 1); ++dup) { if (IN(b + 0)) {
            gemm_call(p, layer, 0, 0, smem);
            const int nun = (MT / 256) * (NP / 256), rem = nun % (int)gridDim.x, idle = (int)gridDim.x - rem;
            if (layer + 1 < DEPTH && dup == 0) {
                if (rem == 0) convert_layer(p, (float*)smem, layer + 1, blockIdx.x, gridDim.x);
                else if ((int)blockIdx.x >= rem) convert_layer(p, (float*)smem, layer + 1, (int)blockIdx.x - rem, idle);
            } }
        SEAM(b + 0); }
        for (int dup = 0; dup < 1 + ((PROBE_DUP >> 1) & 1); ++dup) { if (IN(b + 1)) phase_mixprep(p, layer, smem);
        SEAM(b + 1); }
        for (int dup = 0; dup < 1 + ((PROBE_DUP >> 3) & 1); ++dup) { if (IN(b + 3)) phase_attn(p, smem);
        SEAM(b + 3); }
        for (int dup = 0; dup < 1 + ((PROBE_DUP >> 4) & 1); ++dup) { if (IN(b + 4)) { for (int rep = 0; rep < 3; ++rep) gemm_call(p, layer, 4, rep, smem); }
        SEAM(b + 4); }
        if (IN(b + 5)) gemm_call(p, layer, 5, 0, smem);
        SEAM(b + 5);
        if (IN(b + 6)) {
            float* X = (float*)(p.ws + WS_X);
            if (layer + 1 < DEPTH) rmsnorm_rows(X, p.norm_g + (size_t)(layer + 1) * DM, (bf16_t*)(p.ws + WS_H), nullptr);
            else rmsnorm_rows(X, p.final_g, nullptr, p.out);
        }
        SEAM(b + 6);
    }
#undef IN
#undef SEAM
}

#endif

extern "C" void kernel_launch(void* const* d_in, const int* in_sizes, int n_in, void* d_out, int out_size, void* d_ws, size_t ws_size, hipStream_t stream) {
    static int grid_blocks = 0;
    if (!grid_blocks) {
        if (n_in != 12 || out_size != MT * DM || ws_size < WS_END) { fprintf(stderr, "kernel_launch: unexpected shapes (n_in %d out %d ws %zu need %zu)\n", n_in, out_size, ws_size, (size_t)WS_END); grid_blocks = -1; return; }
        int dev = 0, cus = 0;
        (void)hipGetDevice(&dev);
        (void)hipDeviceGetAttribute(&cus, hipDeviceAttributeMultiprocessorCount, dev);
        bool ok = true;
#if MULTI_LAUNCH
        ok = ok && hipFuncSetAttribute((const void*)k_prep, hipFuncAttributeMaxDynamicSharedMemorySize, LDS_BYTES) == hipSuccess;
        ok = ok && hipFuncSetAttribute((const void*)k_gemm, hipFuncAttributeMaxDynamicSharedMemorySize, LDS_BYTES) == hipSuccess;
        ok = ok && hipFuncSetAttribute((const void*)k_mix, hipFuncAttributeMaxDynamicSharedMemorySize, LDS_BYTES) == hipSuccess;
        ok = ok && hipFuncSetAttribute((const void*)k_attn, hipFuncAttributeMaxDynamicSharedMemorySize, LDS_BYTES) == hipSuccess;
#else
        ok = ok && hipFuncSetAttribute((const void*)fwd_megakernel, hipFuncAttributeMaxDynamicSharedMemorySize, LDS_BYTES) == hipSuccess;
        int per_cu = 0;
        (void)hipOccupancyMaxActiveBlocksPerMultiprocessor(&per_cu, (const void*)fwd_megakernel, 512, LDS_BYTES);
        if (per_cu < 1) fprintf(stderr, "kernel_launch: occupancy query says %d blocks per CU\n", per_cu);
#endif
        if (!ok) { fprintf(stderr, "kernel_launch: hipFuncSetAttribute failed\n"); grid_blocks = -1; return; }
        grid_blocks = cus > 0 ? cus : 256;
    }
    if (grid_blocks < 0) return;
    Params p{};
    p.x = (const float*)d_in[0]; p.norm_g = (const float*)d_in[1]; p.w_in = (const float*)d_in[2]; p.a_ws = (const float*)d_in[3]; p.a_b = (const float*)d_in[4];
    p.b_conv = (const float*)d_in[5]; p.p_a = (const float*)d_in[6]; p.p_b = (const float*)d_in[7]; p.p_c = (const float*)d_in[8]; p.w_o = (const float*)d_in[9];
    p.rel_bias = (const float*)d_in[10]; p.final_g = (const float*)d_in[11];
    p.out = (float*)d_out; p.ws = (unsigned char*)d_ws;
#if MULTI_LAUNCH
    const dim3 G(grid_blocks), B(512);
    hipLaunchKernelGGL(k_prep, G, B, LDS_BYTES, stream, p);
    for (int layer = 0; layer < DEPTH; ++layer) {
        hipLaunchKernelGGL(k_gemm, G, B, LDS_BYTES, stream, p, layer, 0, 0);
        hipLaunchKernelGGL(k_mix, G, B, LDS_BYTES, stream, p, layer);
        hipLaunchKernelGGL(k_attn, G, B, LDS_BYTES, stream, p);
        for (int rep = 0; rep < 3; ++rep) hipLaunchKernelGGL(k_gemm, G, B, LDS_BYTES, stream, p, layer, 4, rep);
        hipLaunchKernelGGL(k_gemm, G, B, LDS_BYTES, stream, p, layer, 5, 0);
        hipLaunchKernelGGL(k_norm, G, B, 0, stream, p, layer);
    }
#else
    p.ph_lo = 0; p.ph_hi = NPHASES;
    (void)hipMemsetAsync((unsigned char*)d_ws + WS_BAR, 0, 16384, stream);
    void* args[] = {&p};
    hipError_t e = hipLaunchCooperativeKernel((const void*)fwd_megakernel, dim3(grid_blocks), dim3(512), args, LDS_BYTES, stream);
    if (e != hipSuccess) fprintf(stderr, "cooperative launch failed: %s (grid %d)\n", hipGetErrorString(e), grid_blocks);
#endif
}
```
